# Optimizing an MI355X kernel written in HIP

```python
import math
import jax, jax.numpy as jnp
from jax import lax
import numpy as np

D_MODEL = 2048
BATCH = 4
SEQ = 4096
DEPTH = 1

A_HEADS = 8
A_HEAD_DIM = 64
A_V_DIM = 2 * A_HEAD_DIM
A_WIDTH = A_HEADS * A_V_DIM
B_HEADS = 8
B_Q_LORA = 512
B_KV_LORA = 512
B_NOPE = 128
B_ROPE = 64
B_V_DIM = 128
B_WIDTH = B_HEADS * B_V_DIM
N_BRANCH = 2

ROPE_THETA = 10000.0
NORM_EPS = 1e-6
SUBLN_EPS = 1e-5
Q_BLOCK = 128

A_Q_COLS = A_HEADS * 2 * A_HEAD_DIM
A_K_COLS = A_HEADS * 2 * A_HEAD_DIM
A_V_COLS = A_WIDTH
A_G_COLS = A_WIDTH
B_CQ_COLS = B_Q_LORA
B_CKV_COLS = B_KV_LORA
B_KR_COLS = B_ROPE
B_G_COLS = B_WIDTH
MERGE_COLS = N_BRANCH * D_MODEL
_SIZES = [A_Q_COLS, A_K_COLS, A_V_COLS, A_G_COLS, B_CQ_COLS, B_CKV_COLS, B_KR_COLS, B_G_COLS, MERGE_COLS]
IN_COLS = sum(_SIZES)
SPLIT_POINTS = [int(v) for v in np.cumsum(_SIZES)[:-1]]

kernel_name = "hybrid_diffattn_mla_gated_encoder"


def _rmsnorm(x, g, eps=NORM_EPS):
    xf = x.astype(jnp.float32)
    y = xf * lax.rsqrt(jnp.mean(xf * xf, axis=-1, keepdims=True) + eps)
    return y.astype(x.dtype) * g


def _lambda_init(layer_idx):
    return 0.8 - 0.6 * math.exp(-0.3 * layer_idx)


def _alibi_slopes(n_heads):
    return jnp.asarray([2.0 ** (-8.0 * (h + 1) / n_heads) for h in range(n_heads)], dtype=jnp.float32)


def _rope_cos_sin(pos):
    half = B_ROPE // 2
    inv = ROPE_THETA ** (-jnp.arange(half, dtype=jnp.float32) / half)
    ang = pos.astype(jnp.float32)[..., None] * inv
    return jnp.cos(ang), jnp.sin(ang)


def _apply_rope(t, cos, sin):
    half = t.shape[-1] // 2
    t1 = t[..., :half].astype(jnp.float32)
    t2 = t[..., half:].astype(jnp.float32)
    out = jnp.concatenate([t1 * cos - t2 * sin, t1 * sin + t2 * cos], axis=-1)
    return out.astype(t.dtype)


def _to_blocks(t):
    b, s = t.shape[0], t.shape[1]
    nb = s // Q_BLOCK
    return t.reshape(b, nb, Q_BLOCK, *t.shape[2:]).swapaxes(0, 1)


def _from_blocks(t):
    nb, b = t.shape[0], t.shape[1]
    return t.swapaxes(0, 1).reshape(b, nb * Q_BLOCK, *t.shape[3:])


def _diff_attention(q1, q2, k1, k2, v, pos_f, lam, slopes):
    scale = A_HEAD_DIM ** -0.5

    def one_block(args):
        qb1, qb2, pb = args
        dist = jnp.abs(pb[:, :, None] - pos_f[:, None, :])
        bias = -slopes[None, :, None, None] * dist[:, None]
        s1 = jnp.einsum('bqhd,bkhd->bhqk', qb1, k1).astype(jnp.float32) * scale + bias
        s2 = jnp.einsum('bqhd,bkhd->bhqk', qb2, k2).astype(jnp.float32) * scale + bias
        p = jax.nn.softmax(s1, axis=-1) - lam * jax.nn.softmax(s2, axis=-1)
        return jnp.einsum('bhqk,bkhe->bqhe', p.astype(v.dtype), v)

    out = lax.map(one_block, (_to_blocks(q1), _to_blocks(q2), _to_blocks(pos_f)))
    return _from_blocks(out)


def _mla_attention(q_nope, q_rope, k_nope, k_rope, v):
    scale = (B_NOPE + B_ROPE) ** -0.5

    def one_block(args):
        qn, qr = args
        s = (jnp.einsum('bqhd,bkhd->bhqk', qn, k_nope)
             + jnp.einsum('bqhr,bkr->bhqk', qr, k_rope)).astype(jnp.float32) * scale
        p = jax.nn.softmax(s, axis=-1)
        return jnp.einsum('bhqk,bkhe->bqhe', p.astype(v.dtype), v)

    out = lax.map(one_block, (_to_blocks(q_nope), _to_blocks(q_rope)))
    return _from_blocks(out)


def setup_inputs(seed: int = 0) -> dict:
    key = jax.random.key(seed)
    ks = jax.random.split(key, 20)
    f32 = jnp.float32
    nrm = lambda k, shape, fan_in: jax.random.normal(k, shape, f32) * (fan_in ** -0.5)
    gain = lambda k, shape: 1.0 + 0.02 * jax.random.normal(k, shape, f32)
    x = jax.random.normal(ks[0], (BATCH, SEQ, D_MODEL), f32)
    offsets = jax.random.randint(ks[1], (BATCH, 1), 0, 1024, dtype=jnp.int32)
    positions = (jnp.arange(SEQ, dtype=jnp.int32)[None, :] + offsets).astype(jnp.int32)
    return {
        "x": x,
        "positions": positions,
        "norm_g": gain(ks[2], (DEPTH, D_MODEL)),
        "w_in": nrm(ks[3], (DEPTH, D_MODEL, IN_COLS), D_MODEL),
        "lam_q1": 0.1 * jax.random.normal(ks[4], (DEPTH, A_HEAD_DIM), f32),
        "lam_k1": 0.1 * jax.random.normal(ks[5], (DEPTH, A_HEAD_DIM), f32),
        "lam_q2": 0.1 * jax.random.normal(ks[6], (DEPTH, A_HEAD_DIM), f32),
        "lam_k2": 0.1 * jax.random.normal(ks[7], (DEPTH, A_HEAD_DIM), f32),
        "a_subln_g": gain(ks[8], (DEPTH, A_V_DIM)),
        "w_oa": nrm(ks[9], (DEPTH, A_WIDTH, D_MODEL), A_WIDTH),
        "q_norm_g": gain(ks[10], (DEPTH, B_Q_LORA)),
        "w_uq": nrm(ks[11], (DEPTH, B_Q_LORA, B_HEADS * (B_NOPE + B_ROPE)), B_Q_LORA),
        "kv_norm_g": gain(ks[12], (DEPTH, B_KV_LORA)),
        "w_ukv": nrm(ks[13], (DEPTH, B_KV_LORA, B_HEADS * (B_NOPE + B_V_DIM)), B_KV_LORA),
        "w_ob": nrm(ks[14], (DEPTH, B_WIDTH, D_MODEL), B_WIDTH),
        "w_out": nrm(ks[15], (DEPTH, D_MODEL, D_MODEL), D_MODEL),
        "final_g": gain(ks[16], (D_MODEL,)),
    }


def reference(x, positions, norm_g, w_in, lam_q1, lam_k1, lam_q2, lam_k2, a_subln_g, w_oa,
              q_norm_g, w_uq, kv_norm_g, w_ukv, w_ob, w_out, final_g):
    b, s, _ = x.shape
    pos_f = positions.astype(jnp.float32)
    slopes = _alibi_slopes(A_HEADS)
    cos, sin = _rope_cos_sin(positions)
    for layer in range(DEPTH):
        lam_init = _lambda_init(layer)
        h = _rmsnorm(x, norm_g[layer])
        proj = h @ w_in[layer]
        aq, ak, av, ag, cq, ckv, kr, bg, mg = jnp.split(proj, SPLIT_POINTS, axis=-1)

        aq = aq.reshape(b, s, A_HEADS, 2, A_HEAD_DIM)
        ak = ak.reshape(b, s, A_HEADS, 2, A_HEAD_DIM)
        av = av.reshape(b, s, A_HEADS, A_V_DIM)
        lam = (jnp.exp(jnp.sum(lam_q1[layer].astype(jnp.float32) * lam_k1[layer].astype(jnp.float32)))
               - jnp.exp(jnp.sum(lam_q2[layer].astype(jnp.float32) * lam_k2[layer].astype(jnp.float32)))
               + lam_init)
        oa = _diff_attention(aq[..., 0, :], aq[..., 1, :], ak[..., 0, :], ak[..., 1, :], av,
                             pos_f, lam, slopes)
        oa = _rmsnorm(oa, a_subln_g[layer], SUBLN_EPS) * (1.0 - lam_init)
        ya = (oa.reshape(b, s, A_WIDTH) * jax.nn.silu(ag)) @ w_oa[layer]

        q = (_rmsnorm(cq, q_norm_g[layer]) @ w_uq[layer]).reshape(b, s, B_HEADS, B_NOPE + B_ROPE)
        kv = (_rmsnorm(ckv, kv_norm_g[layer]) @ w_ukv[layer]).reshape(b, s, B_HEADS, B_NOPE + B_V_DIM)
        q_nope, q_rope = q[..., :B_NOPE], q[..., B_NOPE:]
        k_nope, vb = kv[..., :B_NOPE], kv[..., B_NOPE:]
        q_rope = _apply_rope(q_rope, cos[:, :, None, :], sin[:, :, None, :])
        k_rope = _apply_rope(kr, cos, sin)
        ob = _mla_attention(q_nope, q_rope, k_nope, k_rope, vb)
        yb = (ob.reshape(b, s, B_WIDTH) * jax.nn.silu(bg)) @ w_ob[layer]

        ga, gb = jnp.split(mg, 2, axis=-1)
        merged = jax.nn.sigmoid(ga) * ya + jax.nn.sigmoid(gb) * yb
        x = x + merged @ w_out[layer]
    return _rmsnorm(x, final_g)
```

```cpp
#include <hip/hip_runtime.h>
#include <cstdio>
#include <cstdint>

#define GAS __attribute__((address_space(1)))
#define LAS __attribute__((address_space(3)))
typedef unsigned short bf16;
typedef short bf16x8 __attribute__((ext_vector_type(8)));
typedef float f32x4 __attribute__((ext_vector_type(4)));
typedef float f32x2 __attribute__((ext_vector_type(2)));
typedef unsigned u32x4 __attribute__((ext_vector_type(4)));
typedef unsigned u32x2 __attribute__((ext_vector_type(2)));

#ifndef MK_N_LAUNCHES
#define MK_N_LAUNCHES 1
#endif
#ifndef NAIVE_P1
#define NAIVE_P1 1
#endif
#ifndef NAIVE_P2
#define NAIVE_P2 1
#endif
#ifndef NAIVE_P3
#define NAIVE_P3 1
#endif
#ifndef NAIVE_P4
#define NAIVE_P4 1
#endif
#ifndef NAIVE_P5
#define NAIVE_P5 1
#endif

constexpr int NB = 4, SEQ = 4096, T = NB * SEQ, DM = 2048;
constexpr int IN_COLS = 10304;
constexpr int OFF_AQ = 0, OFF_AK = 1024, OFF_AV = 2048, OFF_AG = 3072, OFF_CQ = 4096, OFF_CKV = 4608, OFF_KR = 5120, OFF_BG = 5184, OFF_MG = 6208;
constexpr int NP1 = 41 * 256;
constexpr int NQ = 1536, NKV = 2048;
constexpr int NWAVES = 8, NPHASE = 7;
constexpr float NORM_EPS = 1e-6f, SUBLN_EPS = 1e-5f, LAM_INIT = 0.2f;

constexpr size_t MiB = 1u << 20;
constexpr size_t WS_CTL = 0, CTL_ZERO_BYTES = 1 * MiB;
constexpr size_t WS_RSTDX = 1 * MiB;
constexpr size_t WS_SSQQ = WS_RSTDX + 256 * 1024;
constexpr size_t WS_SSQKV = WS_SSQQ + 512 * 1024;
constexpr size_t WS_ROWSS = 3 * MiB;
constexpr size_t WS_CS = 5 * MiB;
constexpr size_t WS_WUQ = 9 * MiB;
constexpr size_t WS_WUKV = 11 * MiB;
constexpr size_t WS_WOAB = 13 * MiB;
constexpr size_t WS_WOUT = 21 * MiB;
constexpr size_t WS_KR = 29 * MiB;
constexpr size_t WS_XB = 32 * MiB;
constexpr size_t WS_KV = WS_XB;
constexpr size_t WS_WIN = 96 * MiB;
constexpr size_t WS_Q = WS_WIN;
constexpr size_t WS_AQ = 144 * MiB, WS_AK = 176 * MiB, WS_AV = 208 * MiB;
constexpr size_t WS_MERGED = WS_AQ;
constexpr size_t WS_CQ = 240 * MiB, WS_CKV = 256 * MiB;
constexpr size_t WS_R = 272 * MiB, WS_SB = 336 * MiB;
constexpr size_t WS_END = 400 * MiB;
constexpr size_t DO_ABIN = 0, DO_AGS = 64 * MiB, DO_BGS = 96 * MiB;

constexpr int CW_TMO = 0, CW_CODE = 1, CW_BAR = 4096;

constexpr int RING_BYTES = 131072;
constexpr int LDSCTL_OFF = 140 * 1024, MISC_OFF = LDSCTL_OFF + 320;
constexpr int LDS_BYTES = 147456;

#define RLX_AGENT __ATOMIC_RELAXED, __HIP_MEMORY_SCOPE_AGENT
#define LDS_WAIT() asm volatile("s_waitcnt lgkmcnt(0)" ::: "memory")
#define VM_WAIT() asm volatile("s_waitcnt vmcnt(0)" ::: "memory")
__device__ __forceinline__ unsigned f2bf(float f) { unsigned u = __builtin_bit_cast(unsigned, f); return (u + 0x7fffu + ((u >> 16) & 1u)) >> 16; }
__device__ __forceinline__ unsigned pk2(float lo, float hi) { return f2bf(lo) | (f2bf(hi) << 16); }
__device__ __forceinline__ float bf2f(unsigned short b) { return __builtin_bit_cast(float, (unsigned)b << 16); }
__device__ __forceinline__ float bflo(unsigned w) { return __builtin_bit_cast(float, w << 16); }
__device__ __forceinline__ float bfhi(unsigned w) { return __builtin_bit_cast(float, w & 0xffff0000u); }
__device__ __forceinline__ float silu_f(float v) { return v / (1.f + __expf(-v)); }
__device__ __forceinline__ float sigm_f(float v) { return 1.f / (1.f + __expf(-v)); }
__device__ __forceinline__ float wave_sum(float v) {
#pragma unroll
    for (int o = 1; o < 64; o <<= 1) v += __shfl_xor(v, o);
    return v;
}
__device__ __forceinline__ float wave_max(float v) {
#pragma unroll
    for (int o = 1; o < 64; o <<= 1) v = fmaxf(v, __shfl_xor(v, o));
    return v;
}

#define XB_TMO      128
#define XB_XCNT(j)  (256  + 64 * (j))
#define XB_XSUB(j)  (1280 + 64 * (j))
#define XB_XGEN(j)  (2304 + 64 * (j))
#define XB_TOP      3328
#define XB_TOPGEN   3392
#define XCD_BAR_WORDS 3456
#define XB_SPIN_CAP (1u << 18)
__device__ __forceinline__ unsigned xb_ld(unsigned* p)              { return __hip_atomic_load(p, __ATOMIC_RELAXED, __HIP_MEMORY_SCOPE_AGENT); }
__device__ __forceinline__ unsigned xb_add(unsigned* p, unsigned v) { return __hip_atomic_fetch_add(p, v, __ATOMIC_RELAXED, __HIP_MEMORY_SCOPE_AGENT); }
__device__ __forceinline__ unsigned xb_xcc_id() { return (unsigned)__builtin_amdgcn_s_getreg((3 << 11) | 20) & 0xFu; }
#define XB_SPIN(cond, bar) do { unsigned _sp = 0; while (cond) { __builtin_amdgcn_s_sleep(1); \
    if ((++_sp & 255u) == 0u) { if (xb_ld(&(bar)[XB_TMO])) break; if (_sp > XB_SPIN_CAP) { atomicAdd(&(bar)[XB_TMO], 1u); break; } } } } while (0)
struct XcdBarrier { unsigned* bar; unsigned x; volatile LAS unsigned* st; };
__device__ __forceinline__ XcdBarrier xcd_barrier_post(unsigned* bar, volatile LAS unsigned* st) {
    XcdBarrier b; b.bar = bar; b.x = xb_xcc_id(); b.st = st;
    if (threadIdx.x == 0) (void)xb_add(&bar[XB_XCNT(b.x)], 1u);
    return b;
}
__device__ __forceinline__ void xcd_barrier_complete(unsigned* bar, unsigned x, unsigned& nloc, unsigned& nx) {
    const unsigned G = gridDim.x * gridDim.y * gridDim.z;
    unsigned sum, cnt, mine, sp = 0u;
    for (;;) {
        sum = 0u; cnt = 0u; mine = 0u;
#pragma unroll
        for (unsigned j = 0; j < 16; ++j) { const unsigned c = xb_ld(&bar[XB_XCNT(j)]); sum += c; cnt += (c > 0u) ? 1u : 0u; mine = (j == x) ? c : mine; }
        if (sum == G) break;
        __builtin_amdgcn_s_sleep(1);
        if ((++sp & 255u) == 0u) { if (xb_ld(&bar[XB_TMO])) break; if (sp > XB_SPIN_CAP) { atomicAdd(&bar[XB_TMO], 1u); break; } }
    }
    nloc = mine > 0u ? mine : 1u; nx = cnt > 0u ? cnt : 1u;
}
__device__ __forceinline__ void xcd_barrier(const XcdBarrier& b) {
    asm volatile("s_waitcnt vmcnt(0)" ::: "memory");
    __syncthreads();
    if (threadIdx.x == 0) {
        unsigned* bar = b.bar;
        __builtin_amdgcn_s_waitcnt(0);
        unsigned nloc = b.st[0], nx = b.st[1];
        if (nloc == 0u) { xcd_barrier_complete(bar, b.x, nloc, nx); b.st[0] = nloc; b.st[1] = nx; }
        const unsigned old = xb_add(&bar[XB_XSUB(b.x)], 1u);
        const unsigned gen = old / nloc;
        if (old + 1u == (gen + 1u) * nloc) {
            __builtin_amdgcn_fence(__ATOMIC_RELEASE, "agent");
            asm volatile("s_waitcnt vmcnt(0)" ::: "memory");
            const unsigned og = xb_add(&bar[XB_TOP], 1u);
            const unsigned tg = og / nx;
            if (og + 1u == (tg + 1u) * nx) xb_add(&bar[XB_TOPGEN], 1u);
            else XB_SPIN(xb_ld(&bar[XB_TOPGEN]) == tg, bar);
            __builtin_amdgcn_fence(__ATOMIC_ACQUIRE, "agent");
            xb_add(&bar[XB_XGEN(b.x)], 1u);
            asm volatile("s_waitcnt vmcnt(0)" ::: "memory");
        } else {
            XB_SPIN(xb_ld(&bar[XB_XGEN(b.x)]) == gen, bar);
            __builtin_amdgcn_fence(__ATOMIC_ACQUIRE, "agent");
            asm volatile("s_waitcnt vmcnt(0)" ::: "memory");
        }
    }
    __syncthreads();
}

struct Args { const void* in[17]; float* out; unsigned char* ws; int ph_lo, ph_hi, li, pad; };
struct Frame {
    LAS unsigned char* lds;
    volatile LAS unsigned* MISC;
    int tid, lane, wave, vcu, G;
    const void* const* in; float* out; unsigned char* ws;
};
#define IN_X(F)      ((const float*)(F).in[0])
#define IN_POS(F)    ((const int*)(F).in[1])
#define IN_NORMG(F)  ((const float*)(F).in[2])
#define IN_WIN(F)    ((const float*)(F).in[3])
#define IN_LQ1(F)    ((const float*)(F).in[4])
#define IN_LK1(F)    ((const float*)(F).in[5])
#define IN_LQ2(F)    ((const float*)(F).in[6])
#define IN_LK2(F)    ((const float*)(F).in[7])
#define IN_SUBLNG(F) ((const float*)(F).in[8])
#define IN_WOA(F)    ((const float*)(F).in[9])
#define IN_QNG(F)    ((const float*)(F).in[10])
#define IN_WUQ(F)    ((const float*)(F).in[11])
#define IN_KVNG(F)   ((const float*)(F).in[12])
#define IN_WUKV(F)   ((const float*)(F).in[13])
#define IN_WOB(F)    ((const float*)(F).in[14])
#define IN_WOUT(F)   ((const float*)(F).in[15])
#define IN_FINALG(F) ((const float*)(F).in[16])
#define W_CTL(F)    ((unsigned*)((F).ws + WS_CTL))
#define W_RSTDX(F)  ((float*)((F).ws + WS_RSTDX))
#define W_SSQQ(F)   ((float*)((F).ws + WS_SSQQ))
#define W_SSQKV(F)  ((float*)((F).ws + WS_SSQKV))
#define W_ROWSS(F)  ((float*)((F).ws + WS_ROWSS))
#define W_CS(F)     ((f32x2*)((F).ws + WS_CS))
#define W_WIN(F)    ((bf16*)((F).ws + WS_WIN))
#define W_WUQ(F)    ((bf16*)((F).ws + WS_WUQ))
#define W_WUKV(F)   ((bf16*)((F).ws + WS_WUKV))
#define W_WOAB(F)   ((bf16*)((F).ws + WS_WOAB))
#define W_WOUT(F)   ((bf16*)((F).ws + WS_WOUT))
#define W_KR(F)     ((bf16*)((F).ws + WS_KR))
#define W_XB(F)     ((bf16*)((F).ws + WS_XB))
#define W_KV(F)     ((bf16*)((F).ws + WS_KV))
#define W_Q(F)      ((bf16*)((F).ws + WS_Q))
#define W_AQ(F)     ((bf16*)((F).ws + WS_AQ))
#define W_AK(F)     ((bf16*)((F).ws + WS_AK))
#define W_AV(F)     ((bf16*)((F).ws + WS_AV))
#define W_MERGED(F) ((bf16*)((F).ws + WS_MERGED))
#define W_CQ(F)     ((bf16*)((F).ws + WS_CQ))
#define W_CKV(F)    ((bf16*)((F).ws + WS_CKV))
#define W_R(F)      ((bf16*)((F).ws + WS_R))
#define W_SB(F)     ((bf16*)((F).ws + WS_SB))
#define W_ABIN(F)   ((bf16*)((unsigned char*)(F).out + DO_ABIN))
#define W_AGS(F)    ((bf16*)((unsigned char*)(F).out + DO_AGS))
#define W_BGS(F)    ((bf16*)((unsigned char*)(F).out + DO_BGS))

__device__ __forceinline__ int win_src_col(int n) {
    const int t = n >> 8, c = n & 255;
    if (t < 20) return n;
    if (t < 24) return OFF_BG + (n - 5120);
    if (t < 40) { const int j = t - 24; return c < 128 ? OFF_MG + 128 * j + c : OFF_MG + 2048 + 128 * j + (c - 128); }
    if (c < 32) return OFF_KR + c;
    if (c >= 128 && c < 160) return OFF_KR + 32 + (c - 128);
    return -1;
}
__device__ __forceinline__ int wuq_src_col(int n) {
    const int t = n >> 8, c = n & 255;
    if (t < 4) return (2 * t + (c >> 7)) * 192 + (c & 127);
    const int u = t - 4, cc = c & 127, hh = 4 * u + (cc >> 5);
    return hh * 192 + 128 + (c >> 7) * 32 + (cc & 31);
}
__device__ __forceinline__ void p0_transpose_item(const float* W, int ldw, int src0, const float* gain, int k0, bf16* WT, int nrow0, int ldt, int kdst0, LAS float* scr, int lane) {
    if (src0 >= 0) {
#pragma unroll 8
        for (int i = 0; i < 32; ++i) { const int kk = 2 * i + (lane >> 5); float v = W[(size_t)(k0 + kk) * ldw + src0 + (lane & 31)]; if (gain) v *= gain[k0 + kk]; scr[kk * 33 + (lane & 31)] = v; }
    } else {
#pragma unroll 8
        for (int i = 0; i < 32; ++i) { const int kk = 2 * i + (lane >> 5); scr[kk * 33 + (lane & 31)] = 0.f; }
    }
    LDS_WAIT(); asm volatile("" ::: "memory");
    const int c = lane & 7;
#pragma unroll
    for (int j = 0; j < 4; ++j) { const int n = (lane >> 3) + 8 * j; const LAS float* s = scr + (8 * c) * 33 + n;
        u32x4 o; o.x = pk2(s[0 * 33], s[1 * 33]); o.y = pk2(s[2 * 33], s[3 * 33]); o.z = pk2(s[4 * 33], s[5 * 33]); o.w = pk2(s[6 * 33], s[7 * 33]);
        *(u32x4*)(WT + (size_t)(nrow0 + n) * ldt + kdst0 + k0 + 8 * c) = o; }
    LDS_WAIT(); asm volatile("" ::: "memory");
}
__device__ __forceinline__ void p0_prologue(Frame& F) {
    LAS float* scr = (LAS float*)(F.lds + F.wave * 16384);
    const int gw = F.vcu * NWAVES + F.wave, NGW = F.G * NWAVES, lane = F.lane;
    constexpr int I_IN = (DM / 64) * (NP1 / 32), I_UQ = (512 / 64) * (NQ / 32), I_UKV = (512 / 64) * (NKV / 32), I_OA = (1024 / 64) * (DM / 32), I_OUT = (DM / 64) * (DM / 32);
    constexpr int NITEMS = I_IN + I_UQ + I_UKV + 2 * I_OA + I_OUT;
    for (int it = gw; it < NITEMS; it += NGW) {
        int r = it;
        if (r < I_IN) { const int nb = r % (NP1 / 32), kb = r / (NP1 / 32); p0_transpose_item(IN_WIN(F), IN_COLS, win_src_col(nb * 32), IN_NORMG(F), kb * 64, W_WIN(F), nb * 32, DM, 0, scr, lane); continue; } r -= I_IN;
        if (r < I_UQ) { const int nb = r % (NQ / 32), kb = r / (NQ / 32); p0_transpose_item(IN_WUQ(F), NQ, wuq_src_col(nb * 32), IN_QNG(F), kb * 64, W_WUQ(F), nb * 32, 512, 0, scr, lane); continue; } r -= I_UQ;
        if (r < I_UKV) { const int nb = r % (NKV / 32), kb = r / (NKV / 32); p0_transpose_item(IN_WUKV(F), NKV, nb * 32, IN_KVNG(F), kb * 64, W_WUKV(F), nb * 32, 512, 0, scr, lane); continue; } r -= I_UKV;
        if (r < I_OA) { const int nb = r % (DM / 32), kb = r / (DM / 32); p0_transpose_item(IN_WOA(F), DM, nb * 32, nullptr, kb * 64, W_WOAB(F), nb * 32, 2048, 0, scr, lane); continue; } r -= I_OA;
        if (r < I_OA) { const int nb = r % (DM / 32), kb = r / (DM / 32); p0_transpose_item(IN_WOB(F), DM, nb * 32, nullptr, kb * 64, W_WOAB(F), nb * 32, 2048, 1024, scr, lane); continue; } r -= I_OA;
        { const int nb = r % (DM / 32), kb = r / (DM / 32); p0_transpose_item(IN_WOUT(F), DM, nb * 32, nullptr, kb * 64, W_WOUT(F), nb * 32, 2048, 0, scr, lane); }
    }
    for (int m = gw; m < T; m += NGW) {
        const f32x4* xr = (const f32x4*)(IN_X(F) + (size_t)m * DM) + lane;
        f32x4 v[8]; float s = 0.f;
#pragma unroll
        for (int j = 0; j < 8; ++j) { v[j] = xr[64 * j]; s += (v[j].x * v[j].x + v[j].y * v[j].y) + (v[j].z * v[j].z + v[j].w * v[j].w); }
        s = wave_sum(s);
        if (lane == 0) W_RSTDX(F)[m] = 1.0f / sqrtf(s * (1.f / DM) + NORM_EPS);
        u32x2* o8 = (u32x2*)(W_XB(F) + (size_t)m * DM) + lane;
#pragma unroll
        for (int j = 0; j < 8; ++j) { u32x2 w; w.x = pk2(v[j].x, v[j].y); w.y = pk2(v[j].z, v[j].w); o8[64 * j] = w; }
    }
    for (int e = (F.vcu * NWAVES * 64 + F.tid); e < T * 32; e += F.G * NWAVES * 64) {
        const int row = e >> 5, i = e & 31;
        const float inv = exp2f(-(float)i * (13.287712379549449f / 32.f));
        const float ang = (float)IN_POS(F)[row] * inv;
        const double a = (double)ang, n = __builtin_rint(a * 0.15915494309189535), rr = __builtin_fma(-n, 6.283185307179586, a);
        const float rf = (float)rr;
        W_CS(F)[e] = (f32x2){cosf(rf), sinf(rf)};
    }
}

template <class Epi> __device__ __forceinline__ void naive_gemm(const bf16* A, int lda, const bf16* Bt, int ldb, int M, int N, int K, const Epi& epi, int gw, int NGW, int lane, int kmid) {
    const int nN = N / 256, nU = (M / 16) * nN, fr = lane & 15, fq = lane >> 4;
    for (int u = gw; u < nU; u += NGW) {
        const int pn = u % nN, row0 = (u / nN) * 16;
        f32x4 acc[16];
#pragma unroll
        for (int t = 0; t < 16; ++t) acc[t] = (f32x4){0.f, 0.f, 0.f, 0.f};
        const bf16* ap = A + (size_t)(row0 + fr) * lda + 8 * fq; const bf16* bp = Bt + (size_t)(256 * pn + fr) * ldb + 8 * fq;
        for (int k0 = 0; k0 < K; k0 += 32) {
            if (kmid > 0 && k0 == kmid) epi.mid(acc, pn, row0, fr, fq);
            const bf16x8 a = *(const bf16x8*)(ap + k0);
#pragma unroll
            for (int t = 0; t < 16; ++t) { const bf16x8 b = *(const bf16x8*)(bp + (size_t)(16 * t) * ldb + k0); acc[t] = __builtin_amdgcn_mfma_f32_16x16x32_bf16(a, b, acc[t], 0, 0, 0); }
        }
        epi(acc, pn, row0, fr, fq);
    }
}
__device__ __forceinline__ float quad16_sum(float v) { v += __shfl_xor(v, 1); v += __shfl_xor(v, 2); v += __shfl_xor(v, 4); v += __shfl_xor(v, 8); return v; }
struct NEpiP1 {
    Frame F;
    __device__ __forceinline__ void mid(f32x4 (&)[16], int, int, int, int) const {}
    __device__ __forceinline__ void operator()(f32x4 (&acc)[16], int pn, int row0, int fr, int fq) const {
        const Frame& f = F;
#pragma unroll
        for (int i = 0; i < 4; ++i) {
            const int row = row0 + 4 * fq + i; const float rs = W_RSTDX(f)[row];
            if (pn < 16) {
                bf16* dst = pn < 4 ? W_AQ(f) : pn < 8 ? W_AK(f) : pn < 12 ? W_AV(f) : W_AGS(f); const int cb = (pn & 3) * 256 + fr;
#pragma unroll
                for (int t = 0; t < 16; ++t) { float v = acc[t][i] * rs; if (pn >= 12) v = silu_f(v); dst[(size_t)row * 1024 + cb + 16 * t] = (bf16)f2bf(v); }
            } else if (pn < 20) {
                bf16* dst = pn < 18 ? W_CQ(f) : W_CKV(f); float* ssq = pn < 18 ? W_SSQQ(f) : W_SSQKV(f); const int cb = (pn & 1) * 256 + fr; float s = 0.f;
#pragma unroll
                for (int t = 0; t < 16; ++t) { const float v = acc[t][i] * rs; s += v * v; dst[(size_t)row * 512 + cb + 16 * t] = (bf16)f2bf(v); }
                s = quad16_sum(s);
                if (fr < 4) ssq[(size_t)row * 8 + (pn & 1) * 4 + fr] = fr == 0 ? s : 0.f;
            } else if (pn < 24) {
                const int cb = (pn - 20) * 256 + fr;
#pragma unroll
                for (int t = 0; t < 16; ++t) W_BGS(f)[(size_t)row * 1024 + cb + 16 * t] = (bf16)f2bf(silu_f(acc[t][i] * rs));
            } else if (pn < 40) {
                const int cb = (pn - 24) * 128 + fr;
#pragma unroll
                for (int t = 0; t < 8; ++t) { const float sa = sigm_f(acc[t][i] * rs), sb = sigm_f(acc[t + 8][i] * rs);
                    W_R(f)[(size_t)row * 2048 + cb + 16 * t] = (bf16)f2bf(sa / sb); W_SB(f)[(size_t)row * 2048 + cb + 16 * t] = (bf16)f2bf(sb); }
            } else {
#pragma unroll
                for (int t = 0; t < 2; ++t) { const int c = 16 * t + fr; const float x1 = acc[t][i] * rs, x2 = acc[t + 8][i] * rs; const f32x2 cs = W_CS(f)[(size_t)row * 32 + c];
                    W_KR(f)[(size_t)row * 64 + c] = (bf16)f2bf(x1 * cs.x - x2 * cs.y); W_KR(f)[(size_t)row * 64 + 32 + c] = (bf16)f2bf(x1 * cs.y + x2 * cs.x); }
            }
        }
    }
};
__device__ __forceinline__ float rstd8(const float* p, float inv_n, float eps) { const f32x4 a = *(const f32x4*)p, b = *(const f32x4*)(p + 4); const float s = ((a.x + a.y) + (a.z + a.w)) + ((b.x + b.y) + (b.z + b.w)); return 1.0f / sqrtf(s * inv_n + eps); }
struct NEpiQ {
    Frame F;
    __device__ __forceinline__ void mid(f32x4 (&)[16], int, int, int, int) const {}
    __device__ __forceinline__ void operator()(f32x4 (&acc)[16], int pn, int row0, int fr, int fq) const {
        const Frame& f = F;
#pragma unroll
        for (int i = 0; i < 4; ++i) {
            const int row = row0 + 4 * fq + i; const float rs = rstd8(W_SSQQ(f) + (size_t)row * 8, 1.f / 512.f, NORM_EPS);
            if (pn < 4) {
#pragma unroll
                for (int t = 0; t < 16; ++t) { const int c = 16 * t + fr, head = 2 * pn + (c >> 7); W_Q(f)[(size_t)row * NQ + head * 192 + (c & 127)] = (bf16)f2bf(acc[t][i] * rs); }
            } else {
#pragma unroll
                for (int t = 0; t < 8; ++t) { const int c = 16 * t + fr, head = 4 * (pn - 4) + (c >> 5), ii = c & 31; const float x1 = acc[t][i] * rs, x2 = acc[t + 8][i] * rs; const f32x2 cs = W_CS(f)[(size_t)row * 32 + ii];
                    W_Q(f)[(size_t)row * NQ + head * 192 + 128 + ii] = (bf16)f2bf(x1 * cs.x - x2 * cs.y); W_Q(f)[(size_t)row * NQ + head * 192 + 160 + ii] = (bf16)f2bf(x1 * cs.y + x2 * cs.x); }
            }
        }
    }
};
struct NEpiKV {
    Frame F;
    __device__ __forceinline__ void mid(f32x4 (&)[16], int, int, int, int) const {}
    __device__ __forceinline__ void operator()(f32x4 (&acc)[16], int pn, int row0, int fr, int fq) const {
        const Frame& f = F;
#pragma unroll
        for (int i = 0; i < 4; ++i) {
            const int row = row0 + 4 * fq + i; const float rs = rstd8(W_SSQKV(f) + (size_t)row * 8, 1.f / 512.f, NORM_EPS);
#pragma unroll
            for (int t = 0; t < 16; ++t) W_KV(f)[(size_t)row * NKV + pn * 256 + 16 * t + fr] = (bf16)f2bf(acc[t][i] * rs);
        }
    }
};
struct NEpiMerge {
    Frame F;
    __device__ __forceinline__ void mid(f32x4 (&acc)[16], int pn, int row0, int fr, int fq) const {
        const Frame& f = F;
#pragma unroll
        for (int i = 0; i < 4; ++i) { const int row = row0 + 4 * fq + i;
#pragma unroll
            for (int t = 0; t < 16; ++t) acc[t][i] *= bf2f(W_R(f)[(size_t)row * 2048 + pn * 256 + 16 * t + fr]); }
    }
    __device__ __forceinline__ void operator()(f32x4 (&acc)[16], int pn, int row0, int fr, int fq) const {
        const Frame& f = F;
#pragma unroll
        for (int i = 0; i < 4; ++i) { const int row = row0 + 4 * fq + i;
#pragma unroll
            for (int t = 0; t < 16; ++t) { const size_t o = (size_t)row * 2048 + pn * 256 + 16 * t + fr; W_MERGED(f)[o] = (bf16)f2bf(acc[t][i] * bf2f(W_SB(f)[o])); } }
    }
};
struct NEpiOut {
    Frame F;
    __device__ __forceinline__ void mid(f32x4 (&)[16], int, int, int, int) const {}
    __device__ __forceinline__ void operator()(f32x4 (&acc)[16], int pn, int row0, int fr, int fq) const {
        const Frame& f = F;
#pragma unroll
        for (int i = 0; i < 4; ++i) { const int row = row0 + 4 * fq + i; float s = 0.f;
#pragma unroll
            for (int t = 0; t < 16; ++t) { const size_t o = (size_t)row * DM + pn * 256 + 16 * t + fr; const float y = IN_X(f)[o] + acc[t][i]; f.out[o] = y; s += y * y; }
            s = quad16_sum(s);
            if (fr < 4) W_ROWSS(f)[(size_t)row * 32 + pn * 4 + fr] = fr == 0 ? s : 0.f; }
    }
};

template <int DK1, int DK2> __device__ __forceinline__ f32x2 naive_attn_row(Frame& F, const bf16* qrow, const bf16* K1, int ldk1, const bf16* K2, int ldk2, const bf16* V, int ldv,
                                                                          float scale, float slope, float qpos, const int* kpos, LAS float* P, LAS float* qs) {
    const int lane = F.lane;
    for (int d = lane; d < DK1 + DK2; d += 64) qs[d] = bf2f(qrow[d]);
    LDS_WAIT(); asm volatile("" ::: "memory");
    float mx = -1e30f;
    for (int it = 0; it < SEQ / 64; ++it) {
        const int j = it * 64 + lane; float s = 0.f;
        const bf16* kp = K1 + (size_t)j * ldk1;
#pragma unroll
        for (int c = 0; c < DK1 / 8; ++c) { const u32x4 w = *(const u32x4*)(kp + 8 * c);
            s += qs[8 * c + 0] * bflo(w.x) + qs[8 * c + 1] * bfhi(w.x) + qs[8 * c + 2] * bflo(w.y) + qs[8 * c + 3] * bfhi(w.y) + qs[8 * c + 4] * bflo(w.z) + qs[8 * c + 5] * bfhi(w.z) + qs[8 * c + 6] * bflo(w.w) + qs[8 * c + 7] * bfhi(w.w); }
        if (DK2 > 0) { const bf16* kp2 = K2 + (size_t)j * ldk2;
#pragma unroll
            for (int c = 0; c < DK2 / 8; ++c) { const u32x4 w = *(const u32x4*)(kp2 + 8 * c); const LAS float* q2 = qs + DK1 + 8 * c;
                s += q2[0] * bflo(w.x) + q2[1] * bfhi(w.x) + q2[2] * bflo(w.y) + q2[3] * bfhi(w.y) + q2[4] * bflo(w.z) + q2[5] * bfhi(w.z) + q2[6] * bflo(w.w) + q2[7] * bfhi(w.w); } }
        s = s * scale - slope * fabsf(qpos - (float)kpos[j]);
        P[j] = s; mx = fmaxf(mx, s);
    }
    mx = wave_max(mx);
    LDS_WAIT(); asm volatile("" ::: "memory");
    float l = 0.f;
    for (int it = 0; it < SEQ / 64; ++it) { const int j = it * 64 + lane; const float p = __expf(P[j] - mx); P[j] = p; l += p; }
    l = wave_sum(l);
    LDS_WAIT(); asm volatile("" ::: "memory");
    float o0 = 0.f, o1 = 0.f; const bf16* vp = V + 2 * lane;
#pragma unroll 8
    for (int j = 0; j < SEQ; ++j) { const float p = P[j]; const unsigned w = *(const unsigned*)(vp + (size_t)j * ldv); o0 += p * bflo(w); o1 += p * bfhi(w); }
    LDS_WAIT(); asm volatile("" ::: "memory");
    const float il = 1.f / l;
    return (f32x2){o0 * il, o1 * il};
}
__device__ __forceinline__ float lambda_full(Frame& F) {
    const int lane = F.lane;
    const float a = wave_sum(IN_LQ1(F)[lane] * IN_LK1(F)[lane]), b = wave_sum(IN_LQ2(F)[lane] * IN_LK2(F)[lane]);
    return __expf(a) - __expf(b) + LAM_INIT;
}
__device__ __forceinline__ void p3_naive(Frame& F) {
    LAS float* P = (LAS float*)(F.lds) + F.wave * SEQ; LAS float* qs = (LAS float*)(F.lds + 131072) + F.wave * 192;
    const float lam = lambda_full(F); const int lane = F.lane;
    for (int u = F.vcu; u < NB * 8 * (SEQ / 8); u += F.G) {
        const int r8 = u % (SEQ / 8), bh = u / (SEQ / 8), h = bh % 8, b = bh / 8, row = b * SEQ + r8 * 8 + F.wave;
        const float slope = exp2f(-(float)(h + 1)), qpos = (float)IN_POS(F)[row]; const int* kpos = IN_POS(F) + b * SEQ;
        const bf16* kb = W_AK(F) + (size_t)b * SEQ * 1024 + h * 128; const bf16* vb = W_AV(F) + (size_t)b * SEQ * 1024 + h * 128; const bf16* qb = W_AQ(F) + (size_t)row * 1024 + h * 128;
        const f32x2 o1 = naive_attn_row<64, 0>(F, qb, kb, 1024, nullptr, 0, vb, 1024, 0.125f, slope, qpos, kpos, P, qs);
        const f32x2 o2 = naive_attn_row<64, 0>(F, qb + 64, kb + 64, 1024, nullptr, 0, vb, 1024, 0.125f, slope, qpos, kpos, P, qs);
        const float d0 = o1.x - lam * o2.x, d1 = o1.y - lam * o2.y;
        const float ss = wave_sum(d0 * d0 + d1 * d1), rs = 1.0f / sqrtf(ss * (1.f / 128.f) + SUBLN_EPS);
        const unsigned gw_ = *(const unsigned*)(W_AGS(F) + (size_t)row * 1024 + h * 128 + 2 * lane);
        const float y0 = d0 * rs * IN_SUBLNG(F)[2 * lane] * (1.f - LAM_INIT) * bflo(gw_), y1 = d1 * rs * IN_SUBLNG(F)[2 * lane + 1] * (1.f - LAM_INIT) * bfhi(gw_);
        *(unsigned*)(W_ABIN(F) + (size_t)row * 2048 + h * 128 + 2 * lane) = pk2(y0, y1);
    }
    for (int u = F.vcu; u < NB * 8 * (SEQ / 8); u += F.G) {
        const int r8 = u % (SEQ / 8), bh = u / (SEQ / 8), h = bh % 8, b = bh / 8, row = b * SEQ + r8 * 8 + F.wave;
        const bf16* kb = W_KV(F) + (size_t)b * SEQ * NKV + h * 256; const bf16* krb = W_KR(F) + (size_t)b * SEQ * 64; const bf16* qb = W_Q(F) + (size_t)row * NQ + h * 192;
        const f32x2 o = naive_attn_row<128, 64>(F, qb, kb, NKV, krb, 64, kb + 128, NKV, 0.07216878364870322f, 0.f, 0.f, IN_POS(F) + b * SEQ, P, qs);
        const unsigned gw_ = *(const unsigned*)(W_BGS(F) + (size_t)row * 1024 + h * 128 + 2 * lane);
        *(unsigned*)(W_ABIN(F) + (size_t)row * 2048 + 1024 + h * 128 + 2 * lane) = pk2(o.x * bflo(gw_), o.y * bfhi(gw_));
    }
}

__device__ __forceinline__ void p6_final(Frame& F) {
    const int gw = F.vcu * NWAVES + F.wave, NGW = F.G * NWAVES, lane = F.lane;
    for (int m = gw; m < T; m += NGW) {
        float s = lane < 32 ? W_ROWSS(F)[(size_t)m * 32 + lane] : 0.f;
        s = wave_sum(s);
        const float rs = 1.0f / sqrtf(s * (1.f / DM) + NORM_EPS);
        f32x4* yr = (f32x4*)(F.out + (size_t)m * DM) + lane; const f32x4* gr = (const f32x4*)IN_FINALG(F) + lane;
#pragma unroll
        for (int j = 0; j < 8; ++j) { const f32x4 y = yr[64 * j], g = gr[64 * j]; yr[64 * j] = (f32x4){y.x * rs * g.x, y.y * rs * g.y, y.z * rs * g.z, y.w * rs * g.w}; }
    }
}

__global__ void __launch_bounds__(NWAVES * 64, 2) mk_fwd(Args args) {
    extern __shared__ __attribute__((aligned(16))) unsigned char lds[];
    Frame F;
    F.lds = (LAS unsigned char*)lds;
    F.MISC = (volatile LAS unsigned*)(F.lds + MISC_OFF);
    F.tid = threadIdx.x; F.lane = F.tid & 63; F.wave = __builtin_amdgcn_readfirstlane(F.tid >> 6);
    F.G = gridDim.x; { const int bx = blockIdx.x; F.vcu = (F.G % 8 == 0) ? (bx % 8) * (F.G / 8) + bx / 8 : bx; }
    F.in = args.in; F.out = args.out; F.ws = args.ws;
    for (int u = F.tid; u < (LDS_BYTES - LDSCTL_OFF) / 4; u += NWAVES * 64) ((LAS unsigned*)(F.lds + LDSCTL_OFF))[u] = 0u;
    __syncthreads();
    XcdBarrier bar; bar.bar = W_CTL(F) + CW_BAR + args.li * XCD_BAR_WORDS; bar.x = 0; bar.st = nullptr;
    if (MK_N_LAUNCHES != NPHASE) bar = xcd_barrier_post(W_CTL(F) + CW_BAR + args.li * XCD_BAR_WORDS, F.MISC + 8);
#define GRID_BAR() do { if (MK_N_LAUNCHES != NPHASE) xcd_barrier(bar); } while (0)
    const int lo = args.ph_lo, hi = args.ph_hi;
#define IN(k) (lo <= (k) && (k) < hi)
#define BOTH(k) (IN(k) && IN((k) + 1))
    const int gw = F.vcu * NWAVES + F.wave, NGW = F.G * NWAVES;

    if (IN(0)) { p0_prologue(F); if (BOTH(0)) GRID_BAR(); }
    if (IN(1)) {
#if NAIVE_P1
        NEpiP1 e{F}; naive_gemm(W_XB(F), DM, W_WIN(F), DM, T, NP1, DM, e, gw, NGW, F.lane, 0);
#endif
        if (BOTH(1)) GRID_BAR();
    }
    if (IN(2)) {
#if NAIVE_P2
        NEpiQ eq{F}; naive_gemm(W_CQ(F), 512, W_WUQ(F), 512, T, NQ, 512, eq, gw, NGW, F.lane, 0);
        NEpiKV ek{F}; naive_gemm(W_CKV(F), 512, W_WUKV(F), 512, T, NKV, 512, ek, gw, NGW, F.lane, 0);
#endif
        if (BOTH(2)) GRID_BAR();
    }
    if (IN(3)) {
#if NAIVE_P3
        p3_naive(F);
#endif
        if (BOTH(3)) GRID_BAR();
    }
    if (IN(4)) {
#if NAIVE_P4
        NEpiMerge e{F}; naive_gemm(W_ABIN(F), 2048, W_WOAB(F), 2048, T, DM, 2048, e, gw, NGW, F.lane, 1024);
#endif
        if (BOTH(4)) GRID_BAR();
    }
    if (IN(5)) {
#if NAIVE_P5
        NEpiOut e{F}; naive_gemm(W_MERGED(F), 2048, W_WOUT(F), 2048, T, DM, 2048, e, gw, NGW, F.lane, 0);
#endif
        if (BOTH(5)) GRID_BAR();
    }
    if (IN(6)) p6_final(F);
#undef IN
#undef BOTH
}

extern "C" void kernel_launch(void* const* d_in, const int* in_sizes, int n_in, void* d_out, int out_size, void* d_ws, size_t ws_size, hipStream_t stream) {
    static int grid = 0;
    if (grid == 0) {
        if (n_in != 17 || in_sizes[0] != T * DM || out_size != T * DM || ws_size < WS_END) { fprintf(stderr, "kernel_launch: unexpected shapes (n_in %d, in0 %d, out %d, ws %zu)\n", n_in, n_in > 0 ? in_sizes[0] : -1, out_size, ws_size); grid = -1; return; }
        int dev = 0, cus = 0, per_cu = 0;
        if (hipGetDevice(&dev) != hipSuccess || hipDeviceGetAttribute(&cus, hipDeviceAttributeMultiprocessorCount, dev) != hipSuccess) { grid = -1; return; }
        if (hipFuncSetAttribute((const void*)mk_fwd, hipFuncAttributeMaxDynamicSharedMemorySize, LDS_BYTES) != hipSuccess) { fprintf(stderr, "kernel_launch: hipFuncSetAttribute failed\n"); grid = -1; return; }
        if (hipOccupancyMaxActiveBlocksPerMultiprocessor(&per_cu, (const void*)mk_fwd, NWAVES * 64, LDS_BYTES) != hipSuccess || per_cu < 1) { fprintf(stderr, "kernel_launch: occupancy query reports %d blocks per CU\n", per_cu); }
        (void)hipGetLastError();
        grid = cus;
    }
    if (grid < 0) return;
    if (hipMemsetAsync((char*)d_ws + WS_CTL, 0, CTL_ZERO_BYTES, stream) != hipSuccess) { fprintf(stderr, "kernel_launch: memset failed\n"); return; }
    Args a{};
    for (int i = 0; i < 17; ++i) a.in[i] = d_in[i];
    a.out = (float*)d_out; a.ws = (unsigned char*)d_ws;
    for (int li = 0; li < MK_N_LAUNCHES; ++li) {
        if (MK_N_LAUNCHES == NPHASE) { a.ph_lo = li; a.ph_hi = li + 1; } else { a.ph_lo = li * NPHASE / MK_N_LAUNCHES; a.ph_hi = (li + 1) * NPHASE / MK_N_LAUNCHES; }
        a.li = li;
        hipLaunchKernelGGL(mk_fwd, dim3(grid), dim3(NWAVES * 64), LDS_BYTES, stream, a);
        const hipError_t le = hipPeekAtLastError();
        if (le != hipSuccess) { fprintf(stderr, "kernel_launch: launch %d failed: %s\n", li, hipGetErrorName(le)); break; }
    }
}
```

```cpp
#include <hip/hip_runtime.h>
#include <cstdio>
#include <cstdint>

#define GAS __attribute__((address_space(1)))
#define LAS __attribute__((address_space(3)))
typedef unsigned short bf16;
typedef short bf16x8 __attribute__((ext_vector_type(8)));
typedef float f32x4 __attribute__((ext_vector_type(4)));
typedef float f32x2 __attribute__((ext_vector_type(2)));
typedef unsigned u32x4 __attribute__((ext_vector_type(4)));
typedef unsigned u32x2 __attribute__((ext_vector_type(2)));

#ifndef MK_N_LAUNCHES
#define MK_N_LAUNCHES 1
#endif
#ifndef NAIVE_P1
#define NAIVE_P1 0
#endif
#ifndef NAIVE_P2
#define NAIVE_P2 0
#endif
#ifndef NAIVE_P3
#define NAIVE_P3 0
#endif
#ifndef NAIVE_P4
#define NAIVE_P4 0
#endif
#ifndef NAIVE_P5
#define NAIVE_P5 0
#endif

constexpr int NB = 4, SEQ = 4096, T = NB * SEQ, DM = 2048;
constexpr int IN_COLS = 10304;
constexpr int OFF_AQ = 0, OFF_AK = 1024, OFF_AV = 2048, OFF_AG = 3072, OFF_CQ = 4096, OFF_CKV = 4608, OFF_KR = 5120, OFF_BG = 5184, OFF_MG = 6208;
constexpr int NP1 = 41 * 256;
constexpr int NQ = 1536, NKV = 2048;
constexpr int NWAVES = 8, NPHASE = 7;
constexpr float NORM_EPS = 1e-6f, SUBLN_EPS = 1e-5f, LAM_INIT = 0.2f;

constexpr size_t MiB = 1u << 20;
constexpr size_t WS_CTL = 0, CTL_ZERO_BYTES = 1 * MiB;
constexpr size_t WS_RSTDX = 1 * MiB;
constexpr size_t WS_SSQQ = WS_RSTDX + 256 * 1024;
constexpr size_t WS_SSQKV = WS_SSQQ + 512 * 1024;
constexpr size_t WS_ROWSS = 3 * MiB;
constexpr size_t WS_CS = 5 * MiB;
constexpr size_t WS_WUQ = 9 * MiB;
constexpr size_t WS_WUKV = 11 * MiB;
constexpr size_t WS_WOAB = 13 * MiB;
constexpr size_t WS_WOUT = 21 * MiB;
constexpr size_t WS_KR = 29 * MiB;
constexpr size_t WS_XB = 32 * MiB;
constexpr size_t WS_KV = WS_XB;
constexpr size_t WS_WIN = 96 * MiB;
constexpr size_t WS_Q = WS_WIN;
constexpr size_t WS_AQ = 144 * MiB, WS_AK = 176 * MiB, WS_AV = 208 * MiB;
constexpr size_t WS_MERGED = WS_AQ;
constexpr size_t WS_CQ = 240 * MiB, WS_CKV = 256 * MiB;
constexpr size_t WS_R = 272 * MiB, WS_SB = 336 * MiB;
constexpr size_t WS_STASH = 400 * MiB;
constexpr size_t WS_END = 432 * MiB;
constexpr size_t DO_ABIN = 0, DO_AGS = 64 * MiB, DO_BGS = 96 * MiB;

constexpr int CW_TMO = 0, CW_CODE = 1, CW_BAR = 4096;

constexpr int RING_BYTES = 131072;
constexpr int LDSCTL_OFF = 150 * 1024, MISC_OFF = LDSCTL_OFF + 320;
constexpr int LDS_BYTES = 154624;

#define RLX_AGENT __ATOMIC_RELAXED, __HIP_MEMORY_SCOPE_AGENT
#define LDS_WAIT() asm volatile("s_waitcnt lgkmcnt(0)" ::: "memory")
#define VM_WAIT() asm volatile("s_waitcnt vmcnt(0)" ::: "memory")
__device__ __forceinline__ unsigned f2bf(float f) { unsigned u = __builtin_bit_cast(unsigned, f); return (u + 0x7fffu + ((u >> 16) & 1u)) >> 16; }
__device__ __forceinline__ unsigned pk2(float lo, float hi) { return f2bf(lo) | (f2bf(hi) << 16); }
__device__ __forceinline__ float bf2f(unsigned short b) { return __builtin_bit_cast(float, (unsigned)b << 16); }
__device__ __forceinline__ float bflo(unsigned w) { return __builtin_bit_cast(float, w << 16); }
__device__ __forceinline__ float bfhi(unsigned w) { return __builtin_bit_cast(float, w & 0xffff0000u); }
__device__ __forceinline__ float silu_f(float v) { return v / (1.f + __expf(-v)); }
__device__ __forceinline__ float sigm_f(float v) { return 1.f / (1.f + __expf(-v)); }
__device__ __forceinline__ int lane_id() { int l; asm volatile("v_mbcnt_lo_u32_b32 %0, -1, 0\n\tv_mbcnt_hi_u32_b32 %0, -1, %0" : "=v"(l)); return l; }
__device__ __forceinline__ float wave_sum(float v) {
#pragma unroll
    for (int o = 1; o < 64; o <<= 1) v += __shfl_xor(v, o);
    return v;
}
__device__ __forceinline__ float wave_max(float v) {
#pragma unroll
    for (int o = 1; o < 64; o <<= 1) v = fmaxf(v, __shfl_xor(v, o));
    return v;
}

#define XB_TMO      128
#define XB_XCNT(j)  (256  + 64 * (j))
#define XB_XSUB(j)  (1280 + 64 * (j))
#define XB_XGEN(j)  (2304 + 64 * (j))
#define XB_TOP      3328
#define XB_TOPGEN   3392
#define XCD_BAR_WORDS 3456
#define XB_SPIN_CAP (1u << 18)
__device__ __forceinline__ unsigned xb_ld(unsigned* p)              { return __hip_atomic_load(p, __ATOMIC_RELAXED, __HIP_MEMORY_SCOPE_AGENT); }
__device__ __forceinline__ unsigned xb_add(unsigned* p, unsigned v) { return __hip_atomic_fetch_add(p, v, __ATOMIC_RELAXED, __HIP_MEMORY_SCOPE_AGENT); }
__device__ __forceinline__ unsigned xb_xcc_id() { return (unsigned)__builtin_amdgcn_s_getreg((3 << 11) | 20) & 0xFu; }
#define XB_SPIN(cond, bar) do { unsigned _sp = 0; while (cond) { __builtin_amdgcn_s_sleep(1); \
    if ((++_sp & 255u) == 0u) { if (xb_ld(&(bar)[XB_TMO])) break; if (_sp > XB_SPIN_CAP) { atomicAdd(&(bar)[XB_TMO], 1u); break; } } } } while (0)
struct XcdBarrier { unsigned* bar; unsigned x; volatile LAS unsigned* st; };
__device__ __forceinline__ XcdBarrier xcd_barrier_post(unsigned* bar, volatile LAS unsigned* st) {
    XcdBarrier b; b.bar = bar; b.x = xb_xcc_id(); b.st = st;
    if (threadIdx.x == 0) (void)xb_add(&bar[XB_XCNT(b.x)], 1u);
    return b;
}
__device__ __forceinline__ void xcd_barrier_complete(unsigned* bar, unsigned x, unsigned& nloc, unsigned& nx) {
    const unsigned G = gridDim.x * gridDim.y * gridDim.z;
    unsigned sum, cnt, mine, sp = 0u;
    for (;;) {
        sum = 0u; cnt = 0u; mine = 0u;
#pragma unroll
        for (unsigned j = 0; j < 16; ++j) { const unsigned c = xb_ld(&bar[XB_XCNT(j)]); sum += c; cnt += (c > 0u) ? 1u : 0u; mine = (j == x) ? c : mine; }
        if (sum == G) break;
        __builtin_amdgcn_s_sleep(1);
        if ((++sp & 255u) == 0u) { if (xb_ld(&bar[XB_TMO])) break; if (sp > XB_SPIN_CAP) { atomicAdd(&bar[XB_TMO], 1u); break; } }
    }
    nloc = mine > 0u ? mine : 1u; nx = cnt > 0u ? cnt : 1u;
}
__device__ __forceinline__ void xcd_barrier(const XcdBarrier& b) {
    asm volatile("s_waitcnt vmcnt(0)" ::: "memory");
    __syncthreads();
    if (threadIdx.x == 0) {
        unsigned* bar = b.bar;
        __builtin_amdgcn_s_waitcnt(0);
        unsigned nloc = b.st[0], nx = b.st[1];
        if (nloc == 0u) { xcd_barrier_complete(bar, b.x, nloc, nx); b.st[0] = nloc; b.st[1] = nx; }
        const unsigned old = xb_add(&bar[XB_XSUB(b.x)], 1u);
        const unsigned gen = old / nloc;
        if (old + 1u == (gen + 1u) * nloc) {
            __builtin_amdgcn_fence(__ATOMIC_RELEASE, "agent");
            asm volatile("s_waitcnt vmcnt(0)" ::: "memory");
            const unsigned og = xb_add(&bar[XB_TOP], 1u);
            const unsigned tg = og / nx;
            if (og + 1u == (tg + 1u) * nx) xb_add(&bar[XB_TOPGEN], 1u);
            else XB_SPIN(xb_ld(&bar[XB_TOPGEN]) == tg, bar);
            __builtin_amdgcn_fence(__ATOMIC_ACQUIRE, "agent");
            xb_add(&bar[XB_XGEN(b.x)], 1u);
            asm volatile("s_waitcnt vmcnt(0)" ::: "memory");
        } else {
            XB_SPIN(xb_ld(&bar[XB_XGEN(b.x)]) == gen, bar);
            __builtin_amdgcn_fence(__ATOMIC_ACQUIRE, "agent");
            asm volatile("s_waitcnt vmcnt(0)" ::: "memory");
        }
    }
    __syncthreads();
}

struct Args { const void* in[17]; float* out; unsigned char* ws; int ph_lo, ph_hi, li, pad; };
struct Frame {
    LAS unsigned char* lds;
    volatile LAS unsigned* MISC;
    int wave, vcu, G;
    const void* const* in; float* out; unsigned char* ws;
};
#define IN_X(F)      ((const float*)(F).in[0])
#define IN_POS(F)    ((const int*)(F).in[1])
#define IN_NORMG(F)  ((const float*)(F).in[2])
#define IN_WIN(F)    ((const float*)(F).in[3])
#define IN_LQ1(F)    ((const float*)(F).in[4])
#define IN_LK1(F)    ((const float*)(F).in[5])
#define IN_LQ2(F)    ((const float*)(F).in[6])
#define IN_LK2(F)    ((const float*)(F).in[7])
#define IN_SUBLNG(F) ((const float*)(F).in[8])
#define IN_WOA(F)    ((const float*)(F).in[9])
#define IN_QNG(F)    ((const float*)(F).in[10])
#define IN_WUQ(F)    ((const float*)(F).in[11])
#define IN_KVNG(F)   ((const float*)(F).in[12])
#define IN_WUKV(F)   ((const float*)(F).in[13])
#define IN_WOB(F)    ((const float*)(F).in[14])
#define IN_WOUT(F)   ((const float*)(F).in[15])
#define IN_FINALG(F) ((const float*)(F).in[16])
#define W_CTL(F)    ((unsigned*)((F).ws + WS_CTL))
#define W_RSTDX(F)  ((float*)((F).ws + WS_RSTDX))
#define W_SSQQ(F)   ((float*)((F).ws + WS_SSQQ))
#define W_SSQKV(F)  ((float*)((F).ws + WS_SSQKV))
#define W_ROWSS(F)  ((float*)((F).ws + WS_ROWSS))
#define W_CS(F)     ((f32x2*)((F).ws + WS_CS))
#define W_WIN(F)    ((bf16*)((F).ws + WS_WIN))
#define W_WUQ(F)    ((bf16*)((F).ws + WS_WUQ))
#define W_WUKV(F)   ((bf16*)((F).ws + WS_WUKV))
#define W_WOAB(F)   ((bf16*)((F).ws + WS_WOAB))
#define W_WOUT(F)   ((bf16*)((F).ws + WS_WOUT))
#define W_KR(F)     ((bf16*)((F).ws + WS_KR))
#define W_XB(F)     ((bf16*)((F).ws + WS_XB))
#define W_KV(F)     ((bf16*)((F).ws + WS_KV))
#define W_Q(F)      ((bf16*)((F).ws + WS_Q))
#define W_AQ(F)     ((bf16*)((F).ws + WS_AQ))
#define W_AK(F)     ((bf16*)((F).ws + WS_AK))
#define W_AV(F)     ((bf16*)((F).ws + WS_AV))
#define W_MERGED(F) ((bf16*)((F).ws + WS_MERGED))
#define W_CQ(F)     ((bf16*)((F).ws + WS_CQ))
#define W_CKV(F)    ((bf16*)((F).ws + WS_CKV))
#define W_R(F)      ((bf16*)((F).ws + WS_R))
#define W_SB(F)     ((bf16*)((F).ws + WS_SB))
#define W_STASH(F)  ((float*)((F).ws + WS_STASH))
#define W_ABIN(F)   ((bf16*)((unsigned char*)(F).out + DO_ABIN))
#define W_AGS(F)    ((bf16*)((unsigned char*)(F).out + DO_AGS))
#define W_BGS(F)    ((bf16*)((unsigned char*)(F).out + DO_BGS))

__device__ __forceinline__ int win_src_col(int n) {
    const int t = n >> 8, c = n & 255;
    if (t < 20) return n;
    if (t < 24) return OFF_BG + (n - 5120);
    if (t < 40) { const int j = t - 24; return c < 128 ? OFF_MG + 128 * j + c : OFF_MG + 2048 + 128 * j + (c - 128); }
    if (c < 32) return OFF_KR + c;
    if (c >= 128 && c < 160) return OFF_KR + 32 + (c - 128);
    return -1;
}
__device__ __forceinline__ int wuq_src_col(int n) {
    const int t = n >> 8, c = n & 255;
    if (t < 4) return (2 * t + (c >> 7)) * 192 + (c & 127);
    const int u = t - 4, cc = c & 127, hh = 4 * u + (cc >> 5);
    return hh * 192 + 128 + (c >> 7) * 32 + (cc & 31);
}
__device__ __forceinline__ void p0_transpose_item(const float* W, int ldw, int src0, const float* gain, int k0, bf16* WT, int nrow0, int ldt, int kdst0, LAS float* scr, int lane) {
    if (src0 >= 0) {
#pragma unroll 8
        for (int i = 0; i < 32; ++i) { const int kk = 2 * i + (lane >> 5); float v = W[(size_t)(k0 + kk) * ldw + src0 + (lane & 31)]; if (gain) v *= gain[k0 + kk]; scr[kk * 33 + (lane & 31)] = v; }
    } else {
#pragma unroll 8
        for (int i = 0; i < 32; ++i) { const int kk = 2 * i + (lane >> 5); scr[kk * 33 + (lane & 31)] = 0.f; }
    }
    LDS_WAIT(); asm volatile("" ::: "memory");
    const int c = lane & 7;
#pragma unroll
    for (int j = 0; j < 4; ++j) { const int n = (lane >> 3) + 8 * j; const LAS float* s = scr + (8 * c) * 33 + n;
        u32x4 o; o.x = pk2(s[0 * 33], s[1 * 33]); o.y = pk2(s[2 * 33], s[3 * 33]); o.z = pk2(s[4 * 33], s[5 * 33]); o.w = pk2(s[6 * 33], s[7 * 33]);
        *(u32x4*)(WT + (size_t)(nrow0 + n) * ldt + kdst0 + k0 + 8 * c) = o; }
    LDS_WAIT(); asm volatile("" ::: "memory");
}
__device__ __forceinline__ void p0_prologue(Frame& F) {
    LAS float* scr = (LAS float*)(F.lds + F.wave * 16384);
    const int gw = F.vcu * NWAVES + F.wave, NGW = F.G * NWAVES, lane = lane_id();
    constexpr int I_IN = (DM / 64) * (NP1 / 32), I_UQ = (512 / 64) * (NQ / 32), I_UKV = (512 / 64) * (NKV / 32), I_OA = (1024 / 64) * (DM / 32), I_OUT = (DM / 64) * (DM / 32);
    constexpr int NITEMS = I_IN + I_UQ + I_UKV + 2 * I_OA + I_OUT;
    for (int it = gw; it < NITEMS; it += NGW) {
        int r = it;
        if (r < I_IN) { const int nb = r % (NP1 / 32), kb = r / (NP1 / 32); p0_transpose_item(IN_WIN(F), IN_COLS, win_src_col(nb * 32), IN_NORMG(F), kb * 64, W_WIN(F), nb * 32, DM, 0, scr, lane); continue; } r -= I_IN;
        if (r < I_UQ) { const int nb = r % (NQ / 32), kb = r / (NQ / 32); p0_transpose_item(IN_WUQ(F), NQ, wuq_src_col(nb * 32), IN_QNG(F), kb * 64, W_WUQ(F), nb * 32, 512, 0, scr, lane); continue; } r -= I_UQ;
        if (r < I_UKV) { const int nb = r % (NKV / 32), kb = r / (NKV / 32); p0_transpose_item(IN_WUKV(F), NKV, nb * 32, IN_KVNG(F), kb * 64, W_WUKV(F), nb * 32, 512, 0, scr, lane); continue; } r -= I_UKV;
        if (r < I_OA) { const int nb = r % (DM / 32), kb = r / (DM / 32); p0_transpose_item(IN_WOA(F), DM, nb * 32, nullptr, kb * 64, W_WOAB(F), nb * 32, 2048, 0, scr, lane); continue; } r -= I_OA;
        if (r < I_OA) { const int nb = r % (DM / 32), kb = r / (DM / 32); p0_transpose_item(IN_WOB(F), DM, nb * 32, nullptr, kb * 64, W_WOAB(F), nb * 32, 2048, 1024, scr, lane); continue; } r -= I_OA;
        { const int nb = r % (DM / 32), kb = r / (DM / 32); p0_transpose_item(IN_WOUT(F), DM, nb * 32, nullptr, kb * 64, W_WOUT(F), nb * 32, 2048, 0, scr, lane); }
    }
    for (int m = gw; m < T; m += NGW) {
        const f32x4* xr = (const f32x4*)(IN_X(F) + (size_t)m * DM) + lane;
        f32x4 v[8]; float s = 0.f;
#pragma unroll
        for (int j = 0; j < 8; ++j) { v[j] = xr[64 * j]; s += (v[j].x * v[j].x + v[j].y * v[j].y) + (v[j].z * v[j].z + v[j].w * v[j].w); }
        s = wave_sum(s);
        if (lane == 0) W_RSTDX(F)[m] = 1.0f / sqrtf(s * (1.f / DM) + NORM_EPS);
        u32x2* o8 = (u32x2*)(W_XB(F) + (size_t)m * DM) + lane;
#pragma unroll
        for (int j = 0; j < 8; ++j) { u32x2 w; w.x = pk2(v[j].x, v[j].y); w.y = pk2(v[j].z, v[j].w); o8[64 * j] = w; }
    }
    for (int e = (F.vcu * NWAVES * 64 + F.wave * 64 + lane); e < T * 32; e += F.G * NWAVES * 64) {
        const int row = e >> 5, i = e & 31;
        const float inv = exp2f(-(float)i * (13.287712379549449f / 32.f));
        const float ang = (float)IN_POS(F)[row] * inv;
        const double a = (double)ang, n = __builtin_rint(a * 0.15915494309189535), rr = __builtin_fma(-n, 6.283185307179586, a);
        const float rf = (float)rr;
        W_CS(F)[e] = (f32x2){cosf(rf), sinf(rf)};
    }
}

template <class Epi> __device__ __forceinline__ void naive_gemm(const bf16* A, int lda, const bf16* Bt, int ldb, int M, int N, int K, const Epi& epi, int gw, int NGW, int lane, int kmid) {
    const int nN = N / 256, nU = (M / 16) * nN, fr = lane & 15, fq = lane >> 4;
    for (int u = gw; u < nU; u += NGW) {
        const int pn = u % nN, row0 = (u / nN) * 16;
        f32x4 acc[16];
#pragma unroll
        for (int t = 0; t < 16; ++t) acc[t] = (f32x4){0.f, 0.f, 0.f, 0.f};
        const bf16* ap = A + (size_t)(row0 + fr) * lda + 8 * fq; const bf16* bp = Bt + (size_t)(256 * pn + fr) * ldb + 8 * fq;
        for (int k0 = 0; k0 < K; k0 += 32) {
            if (kmid > 0 && k0 == kmid) epi.mid(acc, pn, row0, fr, fq);
            const bf16x8 a = *(const bf16x8*)(ap + k0);
#pragma unroll
            for (int t = 0; t < 16; ++t) { const bf16x8 b = *(const bf16x8*)(bp + (size_t)(16 * t) * ldb + k0); acc[t] = __builtin_amdgcn_mfma_f32_16x16x32_bf16(a, b, acc[t], 0, 0, 0); }
        }
        epi(acc, pn, row0, fr, fq);
    }
}
__device__ __forceinline__ float quad16_sum(float v) { v += __shfl_xor(v, 1); v += __shfl_xor(v, 2); v += __shfl_xor(v, 4); v += __shfl_xor(v, 8); return v; }
struct NEpiP1 {
    Frame F;
    __device__ __forceinline__ void mid(f32x4 (&)[16], int, int, int, int) const {}
    __device__ __forceinline__ void operator()(f32x4 (&acc)[16], int pn, int row0, int fr, int fq) const {
        const Frame& f = F;
#pragma unroll
        for (int i = 0; i < 4; ++i) {
            const int row = row0 + 4 * fq + i; const float rs = W_RSTDX(f)[row];
            if (pn < 16) {
                bf16* dst = pn < 4 ? W_AQ(f) : pn < 8 ? W_AK(f) : pn < 12 ? W_AV(f) : W_AGS(f); const int cb = (pn & 3) * 256 + fr;
#pragma unroll
                for (int t = 0; t < 16; ++t) { float v = acc[t][i] * rs; if (pn >= 12) v = silu_f(v); dst[(size_t)row * 1024 + cb + 16 * t] = (bf16)f2bf(v); }
            } else if (pn < 20) {
                bf16* dst = pn < 18 ? W_CQ(f) : W_CKV(f); float* ssq = pn < 18 ? W_SSQQ(f) : W_SSQKV(f); const int cb = (pn & 1) * 256 + fr; float s = 0.f;
#pragma unroll
                for (int t = 0; t < 16; ++t) { const float v = acc[t][i] * rs; s += v * v; dst[(size_t)row * 512 + cb + 16 * t] = (bf16)f2bf(v); }
                s = quad16_sum(s);
                if (fr < 4) ssq[(size_t)row * 8 + (pn & 1) * 4 + fr] = fr == 0 ? s : 0.f;
            } else if (pn < 24) {
                const int cb = (pn - 20) * 256 + fr;
#pragma unroll
                for (int t = 0; t < 16; ++t) W_BGS(f)[(size_t)row * 1024 + cb + 16 * t] = (bf16)f2bf(silu_f(acc[t][i] * rs));
            } else if (pn < 40) {
                const int cb = (pn - 24) * 128 + fr;
#pragma unroll
                for (int t = 0; t < 8; ++t) { const float sa = sigm_f(acc[t][i] * rs), sb = sigm_f(acc[t + 8][i] * rs);
                    W_R(f)[(size_t)row * 2048 + cb + 16 * t] = (bf16)f2bf(sa / sb); W_SB(f)[(size_t)row * 2048 + cb + 16 * t] = (bf16)f2bf(sb); }
            } else {
#pragma unroll
                for (int t = 0; t < 2; ++t) { const int c = 16 * t + fr; const float x1 = acc[t][i] * rs, x2 = acc[t + 8][i] * rs; const f32x2 cs = W_CS(f)[(size_t)row * 32 + c];
                    W_KR(f)[(size_t)row * 64 + c] = (bf16)f2bf(x1 * cs.x - x2 * cs.y); W_KR(f)[(size_t)row * 64 + 32 + c] = (bf16)f2bf(x1 * cs.y + x2 * cs.x); }
            }
        }
    }
};
__device__ __forceinline__ float rstd8(const float* p, float inv_n, float eps) { const f32x4 a = *(const f32x4*)p, b = *(const f32x4*)(p + 4); const float s = ((a.x + a.y) + (a.z + a.w)) + ((b.x + b.y) + (b.z + b.w)); return 1.0f / sqrtf(s * inv_n + eps); }
struct NEpiQ {
    Frame F;
    __device__ __forceinline__ void mid(f32x4 (&)[16], int, int, int, int) const {}
    __device__ __forceinline__ void operator()(f32x4 (&acc)[16], int pn, int row0, int fr, int fq) const {
        const Frame& f = F;
#pragma unroll
        for (int i = 0; i < 4; ++i) {
            const int row = row0 + 4 * fq + i; const float rs = rstd8(W_SSQQ(f) + (size_t)row * 8, 1.f / 512.f, NORM_EPS);
            if (pn < 4) {
#pragma unroll
                for (int t = 0; t < 16; ++t) { const int c = 16 * t + fr, head = 2 * pn + (c >> 7); W_Q(f)[(size_t)row * NQ + head * 192 + (c & 127)] = (bf16)f2bf(acc[t][i] * rs); }
            } else {
#pragma unroll
                for (int t = 0; t < 8; ++t) { const int c = 16 * t + fr, head = 4 * (pn - 4) + (c >> 5), ii = c & 31; const float x1 = acc[t][i] * rs, x2 = acc[t + 8][i] * rs; const f32x2 cs = W_CS(f)[(size_t)row * 32 + ii];
                    W_Q(f)[(size_t)row * NQ + head * 192 + 128 + ii] = (bf16)f2bf(x1 * cs.x - x2 * cs.y); W_Q(f)[(size_t)row * NQ + head * 192 + 160 + ii] = (bf16)f2bf(x1 * cs.y + x2 * cs.x); }
            }
        }
    }
};
struct NEpiKV {
    Frame F;
    __device__ __forceinline__ void mid(f32x4 (&)[16], int, int, int, int) const {}
    __device__ __forceinline__ void operator()(f32x4 (&acc)[16], int pn, int row0, int fr, int fq) const {
        const Frame& f = F;
#pragma unroll
        for (int i = 0; i < 4; ++i) {
            const int row = row0 + 4 * fq + i; const float rs = rstd8(W_SSQKV(f) + (size_t)row * 8, 1.f / 512.f, NORM_EPS);
#pragma unroll
            for (int t = 0; t < 16; ++t) W_KV(f)[(size_t)row * NKV + pn * 256 + 16 * t + fr] = (bf16)f2bf(acc[t][i] * rs);
        }
    }
};
struct NEpiMerge {
    Frame F;
    __device__ __forceinline__ void mid(f32x4 (&acc)[16], int pn, int row0, int fr, int fq) const {
        const Frame& f = F;
#pragma unroll
        for (int i = 0; i < 4; ++i) { const int row = row0 + 4 * fq + i;
#pragma unroll
            for (int t = 0; t < 16; ++t) acc[t][i] *= bf2f(W_R(f)[(size_t)row * 2048 + pn * 256 + 16 * t + fr]); }
    }
    __device__ __forceinline__ void operator()(f32x4 (&acc)[16], int pn, int row0, int fr, int fq) const {
        const Frame& f = F;
#pragma unroll
        for (int i = 0; i < 4; ++i) { const int row = row0 + 4 * fq + i;
#pragma unroll
            for (int t = 0; t < 16; ++t) { const size_t o = (size_t)row * 2048 + pn * 256 + 16 * t + fr; W_MERGED(f)[o] = (bf16)f2bf(acc[t][i] * bf2f(W_SB(f)[o])); } }
    }
};
struct NEpiOut {
    Frame F;
    __device__ __forceinline__ void mid(f32x4 (&)[16], int, int, int, int) const {}
    __device__ __forceinline__ void operator()(f32x4 (&acc)[16], int pn, int row0, int fr, int fq) const {
        const Frame& f = F;
#pragma unroll
        for (int i = 0; i < 4; ++i) { const int row = row0 + 4 * fq + i; float s = 0.f;
#pragma unroll
            for (int t = 0; t < 16; ++t) { const size_t o = (size_t)row * DM + pn * 256 + 16 * t + fr; const float y = IN_X(f)[o] + acc[t][i]; f.out[o] = y; s += y * y; }
            s = quad16_sum(s);
            if (fr < 4) W_ROWSS(f)[(size_t)row * 32 + pn * 4 + fr] = fr == 0 ? s : 0.f; }
    }
};

template <int DK1, int DK2> __device__ __forceinline__ f32x2 naive_attn_row(Frame& F, const bf16* qrow, const bf16* K1, int ldk1, const bf16* K2, int ldk2, const bf16* V, int ldv,
                                                                          float scale, float slope, float qpos, const int* kpos, LAS float* P, LAS float* qs) {
    const int lane = lane_id();
    for (int d = lane; d < DK1 + DK2; d += 64) qs[d] = bf2f(qrow[d]);
    LDS_WAIT(); asm volatile("" ::: "memory");
    float mx = -1e30f;
    for (int it = 0; it < SEQ / 64; ++it) {
        const int j = it * 64 + lane; float s = 0.f;
        const bf16* kp = K1 + (size_t)j * ldk1;
#pragma unroll
        for (int c = 0; c < DK1 / 8; ++c) { const u32x4 w = *(const u32x4*)(kp + 8 * c);
            s += qs[8 * c + 0] * bflo(w.x) + qs[8 * c + 1] * bfhi(w.x) + qs[8 * c + 2] * bflo(w.y) + qs[8 * c + 3] * bfhi(w.y) + qs[8 * c + 4] * bflo(w.z) + qs[8 * c + 5] * bfhi(w.z) + qs[8 * c + 6] * bflo(w.w) + qs[8 * c + 7] * bfhi(w.w); }
        if (DK2 > 0) { const bf16* kp2 = K2 + (size_t)j * ldk2;
#pragma unroll
            for (int c = 0; c < DK2 / 8; ++c) { const u32x4 w = *(const u32x4*)(kp2 + 8 * c); const LAS float* q2 = qs + DK1 + 8 * c;
                s += q2[0] * bflo(w.x) + q2[1] * bfhi(w.x) + q2[2] * bflo(w.y) + q2[3] * bfhi(w.y) + q2[4] * bflo(w.z) + q2[5] * bfhi(w.z) + q2[6] * bflo(w.w) + q2[7] * bfhi(w.w); } }
        s = s * scale - slope * fabsf(qpos - (float)kpos[j]);
        P[j] = s; mx = fmaxf(mx, s);
    }
    mx = wave_max(mx);
    LDS_WAIT(); asm volatile("" ::: "memory");
    float l = 0.f;
    for (int it = 0; it < SEQ / 64; ++it) { const int j = it * 64 + lane; const float p = __expf(P[j] - mx); P[j] = p; l += p; }
    l = wave_sum(l);
    LDS_WAIT(); asm volatile("" ::: "memory");
    float o0 = 0.f, o1 = 0.f; const bf16* vp = V + 2 * lane;
#pragma unroll 8
    for (int j = 0; j < SEQ; ++j) { const float p = P[j]; const unsigned w = *(const unsigned*)(vp + (size_t)j * ldv); o0 += p * bflo(w); o1 += p * bfhi(w); }
    LDS_WAIT(); asm volatile("" ::: "memory");
    const float il = 1.f / l;
    return (f32x2){o0 * il, o1 * il};
}
__device__ __forceinline__ float lambda_full(Frame& F) {
    const int lane = lane_id();
    const float a = wave_sum(IN_LQ1(F)[lane] * IN_LK1(F)[lane]), b = wave_sum(IN_LQ2(F)[lane] * IN_LK2(F)[lane]);
    return __expf(a) - __expf(b) + LAM_INIT;
}
__device__ __forceinline__ void p3_naive(Frame& F) {
    LAS float* P = (LAS float*)(F.lds) + F.wave * SEQ; LAS float* qs = (LAS float*)(F.lds + 131072) + F.wave * 192;
    const float lam = lambda_full(F); const int lane = lane_id();
    for (int u = F.vcu; u < NB * 8 * (SEQ / 8); u += F.G) {
        const int r8 = u % (SEQ / 8), bh = u / (SEQ / 8), h = bh % 8, b = bh / 8, row = b * SEQ + r8 * 8 + F.wave;
        const float slope = exp2f(-(float)(h + 1)), qpos = (float)IN_POS(F)[row]; const int* kpos = IN_POS(F) + b * SEQ;
        const bf16* kb = W_AK(F) + (size_t)b * SEQ * 1024 + h * 128; const bf16* vb = W_AV(F) + (size_t)b * SEQ * 1024 + h * 128; const bf16* qb = W_AQ(F) + (size_t)row * 1024 + h * 128;
        const f32x2 o1 = naive_attn_row<64, 0>(F, qb, kb, 1024, nullptr, 0, vb, 1024, 0.125f, slope, qpos, kpos, P, qs);
        const f32x2 o2 = naive_attn_row<64, 0>(F, qb + 64, kb + 64, 1024, nullptr, 0, vb, 1024, 0.125f, slope, qpos, kpos, P, qs);
        const float d0 = o1.x - lam * o2.x, d1 = o1.y - lam * o2.y;
        const float ss = wave_sum(d0 * d0 + d1 * d1), rs = 1.0f / sqrtf(ss * (1.f / 128.f) + SUBLN_EPS);
        const unsigned gw_ = *(const unsigned*)(W_AGS(F) + (size_t)row * 1024 + h * 128 + 2 * lane);
        const float y0 = d0 * rs * IN_SUBLNG(F)[2 * lane] * (1.f - LAM_INIT) * bflo(gw_), y1 = d1 * rs * IN_SUBLNG(F)[2 * lane + 1] * (1.f - LAM_INIT) * bfhi(gw_);
        *(unsigned*)(W_ABIN(F) + (size_t)row * 2048 + h * 128 + 2 * lane) = pk2(y0, y1);
    }
    for (int u = F.vcu; u < NB * 8 * (SEQ / 8); u += F.G) {
        const int r8 = u % (SEQ / 8), bh = u / (SEQ / 8), h = bh % 8, b = bh / 8, row = b * SEQ + r8 * 8 + F.wave;
        const bf16* kb = W_KV(F) + (size_t)b * SEQ * NKV + h * 256; const bf16* krb = W_KR(F) + (size_t)b * SEQ * 64; const bf16* qb = W_Q(F) + (size_t)row * NQ + h * 192;
        const f32x2 o = naive_attn_row<128, 64>(F, qb, kb, NKV, krb, 64, kb + 128, NKV, 0.07216878364870322f, 0.f, 0.f, IN_POS(F) + b * SEQ, P, qs);
        const unsigned gw_ = *(const unsigned*)(W_BGS(F) + (size_t)row * 1024 + h * 128 + 2 * lane);
        *(unsigned*)(W_ABIN(F) + (size_t)row * 2048 + 1024 + h * 128 + 2 * lane) = pk2(o.x * bflo(gw_), o.y * bfhi(gw_));
    }
}

namespace pg8 {
constexpr int BM = 256, BK = 64, HALF = 128, HTB = HALF * BK * 2, STAGE_BYTES = 8 * HTB, NXCD = 8, WGM = 8;
__host__ __device__ __forceinline__ int lds_byte(int r, int c) { const int st = (r >> 4) * 2 + (c >> 5), rr = r & 15, cc = c & 31, ob = rr * 64 + cc * 2; return st * 1024 + (ob ^ (((ob >> 9) & 1) << 5)); }
__host__ __device__ __forceinline__ void stage_rc(int b, int& R, int& C) { const int st = b / 1024, sb = b % 1024, swz = sb ^ (((sb >> 9) & 1) << 5); R = (st >> 1) * 16 + swz / 64; C = (st & 1) * 32 + (swz % 64) / 2; }
__host__ __device__ __forceinline__ int perm32(int rho) { const int n = rho >> 4, i = rho & 15; return 8 * (i >> 2) + 4 * n + (i & 3); }
struct Unit { int pm, pn, part; };
struct StaticOrder {
    int nM, nN, nwg, G, c;
    __device__ void init(int M, int N, int G_, int c_) { nM = M / BM; nN = N / BM; nwg = nM * nN; G = G_; c = c_; }
    __device__ bool next(int i, Unit& u) const {
        const long L = (long)i * G + c; if (L >= nwg) return false;
        int wgid = (int)L; { const int q = nwg / NXCD, r = nwg % NXCD, xcd = wgid % NXCD, off = wgid / NXCD; wgid = (xcd < r ? xcd * (q + 1) : r * (q + 1) + (xcd - r) * q) + off; }
        const int nig = WGM * nN, gid = wgid / nig, fm = gid * WGM, gsz = (nM - fm) < WGM ? (nM - fm) : WGM;
        u.pm = fm + ((wgid % nig) % gsz); u.pn = (wgid % nig) / gsz; u.part = 0; return true;
    }
};
__device__ __forceinline__ unsigned cvt_pk_bf16(float lo, float hi) { unsigned r; asm volatile("v_cvt_pk_bf16_f32 %0, %1, %2" : "=v"(r) : "v"(lo), "v"(hi)); return r; }
__device__ __forceinline__ u32x4 pack8(const f32x4 v0, const f32x4 v1) { u32x4 w; w.x = cvt_pk_bf16(v0[0], v0[1]); w.y = cvt_pk_bf16(v0[2], v0[3]); w.z = cvt_pk_bf16(v1[0], v1[1]); w.w = cvt_pk_bf16(v1[2], v1[3]); return w; }
__device__ __forceinline__ void unpack8(const u32x4 w, f32x4& v0, f32x4& v1) { v0 = (f32x4){bflo(w.x), bfhi(w.x), bflo(w.y), bfhi(w.y)}; v1 = (f32x4){bflo(w.z), bfhi(w.z), bflo(w.w), bfhi(w.w)}; }

template <class Epi, class Sched, class Src>
__device__ __forceinline__ void gemm_phase(LAS unsigned char* lds, const int K  , const int nt  , const Sched& S, const Src& P, const Epi& E) {
    const int wid = __builtin_amdgcn_readfirstlane((int)threadIdx.x >> 6), lane = lane_id(), tid = wid * 64 + lane, wr = wid >> 2, wc = wid & 3, fr = lane & 15, fq = lane >> 4;
    unsigned voffA[2], voffB[2];
#pragma unroll
    for (int i = 0; i < 2; ++i) { int R, C; stage_rc(tid * 16 + i * 8192, R, C); const int Rb = Epi::PERM ? ((R & ~31) + perm32(R & 31)) : R;
        voffA[i] = (unsigned)(R * K + C) * 2u; voffB[i] = (unsigned)(Rb * K + C) * 2u; }
    const size_t kstep = (size_t)(BK * 2);
    const size_t hstep = (size_t)HALF * K * 2;
    const unsigned ldsw = (unsigned)wid * 1024u;
    const int aoff = lds_byte(wr * 64 + fr, fq * 8), boff = lds_byte(wc * 32 + fr, fq * 8);
#define PG8_SA(b, h) (((b) * 2 + (h)) * HTB)
#define PG8_SB(b, h) ((4 + (b) * 2 + (h)) * HTB)
#define PG8_STAGE(bufoff, gbase, voff) do { _Pragma("unroll") for (int _i = 0; _i < 2; ++_i) \
        __builtin_amdgcn_global_load_lds((const unsigned*)((const char*)(gbase) + (voff)[_i]), (LAS unsigned*)(lds + (bufoff) + ldsw + _i * 8192), 16, 0, 0); } while (0)
#define PG8_LDA(dst, b, h) do { _Pragma("unroll") for (int m = 0; m < 4; ++m) _Pragma("unroll") for (int k = 0; k < 2; ++k) dst[m][k] = *(const LAS bf16x8*)(lds + PG8_SA(b, h) + aoff + m * 2048 + k * 1024); } while (0)
#define PG8_LDB(dst, b, h) do { _Pragma("unroll") for (int n = 0; n < 2; ++n) _Pragma("unroll") for (int k = 0; k < 2; ++k) dst[n][k] = *(const LAS bf16x8*)(lds + PG8_SB(b, h) + boff + n * 2048 + k * 1024); } while (0)
#define PG8_MMA(ai, bj, At, Bt) do { __builtin_amdgcn_s_setprio(1); _Pragma("unroll") for (int m = 0; m < 4; ++m) _Pragma("unroll") for (int n = 0; n < 2; ++n) _Pragma("unroll") for (int k = 0; k < 2; ++k) \
        acc[ai][bj][m][n] = __builtin_amdgcn_mfma_f32_16x16x32_bf16(Bt[n][k], At[m][k], acc[ai][bj][m][n], 0, 0, 0); __builtin_amdgcn_s_setprio(0); } while (0)
#define PG8_WAIT_V(n) asm volatile("s_waitcnt vmcnt(" #n ")" ::: "memory")
#define PG8_WAIT_L(n) asm volatile("s_waitcnt lgkmcnt(" #n ")" ::: "memory")
#define PG8_BAR __builtin_amdgcn_s_barrier()
#define PG8_SCHED __builtin_amdgcn_sched_barrier(0)
    Unit cur, nxt; int ui = 0;
    if (!S.next(0, cur)) return;
    f32x4 acc[2][2][4][2];
#pragma unroll
    for (int a = 0; a < 2; ++a)
#pragma unroll
        for (int b = 0; b < 2; ++b)
#pragma unroll
            for (int m = 0; m < 4; ++m)
#pragma unroll
                for (int n = 0; n < 2; ++n) acc[a][b][m][n] = (f32x4){0.f, 0.f, 0.f, 0.f};
    bf16x8 At[4][2], B0[2][2], B1[2][2];
    const char* cA = P.a(cur); const char* cB = P.b(cur);
    PG8_STAGE(PG8_SB(0, 0), cB, voffB); PG8_STAGE(PG8_SB(0, 1), cB + hstep, voffB); PG8_STAGE(PG8_SA(0, 0), cA, voffA); PG8_STAGE(PG8_SA(0, 1), cA + hstep, voffA);
    if (wr == 1) PG8_BAR;
    PG8_WAIT_V(2); PG8_BAR;
    PG8_STAGE(PG8_SB(1, 0), cB + kstep, voffB); PG8_STAGE(PG8_SA(1, 0), cA + kstep, voffA); PG8_STAGE(PG8_SB(1, 1), cB + hstep + kstep, voffB);
    PG8_WAIT_V(6); PG8_BAR;
    for (;;) {
        const bool has_next = S.next(ui + 1, nxt);
        const char* nA = has_next ? P.a(nxt) : cA; const char* nB = has_next ? P.b(nxt) : cB;
        for (int t = 0; t < nt; t += 2) {
            const bool last = (t == nt - 2);
            const char* a1 = cA + (size_t)(t + 1) * kstep;
            const char* a2 = last ? nA : cA + (size_t)(t + 2) * kstep; const char* b2 = last ? nB : cB + (size_t)(t + 2) * kstep;
            const char* a3 = a2 + kstep; const char* b3 = b2 + kstep;
            PG8_LDB(B0, 0, 0); PG8_LDB(B1, 0, 1); PG8_SCHED; PG8_LDA(At, 0, 0); PG8_STAGE(PG8_SA(1, 1), a1 + hstep, voffA);
            PG8_WAIT_V(8); PG8_WAIT_L(0); PG8_BAR; PG8_MMA(0, 0, At, B0); PG8_MMA(0, 1, At, B1); PG8_BAR; PG8_SCHED;
            PG8_LDA(At, 0, 1); PG8_STAGE(PG8_SB(0, 0), b2, voffB); PG8_STAGE(PG8_SB(0, 1), b2 + hstep, voffB); PG8_STAGE(PG8_SA(0, 0), a2, voffA);
            PG8_WAIT_V(8); PG8_WAIT_L(0); PG8_BAR; PG8_MMA(1, 0, At, B0); PG8_MMA(1, 1, At, B1); PG8_BAR; PG8_SCHED;
            PG8_LDB(B0, 1, 0); PG8_LDB(B1, 1, 1); PG8_SCHED; PG8_LDA(At, 1, 0); PG8_STAGE(PG8_SA(0, 1), a2 + hstep, voffA);
            PG8_WAIT_V(8); PG8_WAIT_L(0); PG8_BAR; PG8_MMA(0, 0, At, B0); PG8_MMA(0, 1, At, B1); PG8_BAR; PG8_SCHED;
            PG8_LDA(At, 1, 1); PG8_STAGE(PG8_SB(1, 0), b3, voffB); PG8_STAGE(PG8_SB(1, 1), b3 + hstep, voffB); PG8_STAGE(PG8_SA(1, 0), a3, voffA);
            PG8_WAIT_V(8); PG8_WAIT_L(0); PG8_BAR; PG8_MMA(1, 0, At, B0); PG8_MMA(1, 1, At, B1); PG8_BAR; PG8_SCHED;
        }
        if (wr == 0) PG8_BAR;
        E(acc, cur, wr, wc, fr, fq);
        if (!has_next) break;
        if (!Epi::keep(cur)) {
#pragma unroll
        for (int a = 0; a < 2; ++a)
#pragma unroll
            for (int b = 0; b < 2; ++b)
#pragma unroll
                for (int m = 0; m < 4; ++m)
#pragma unroll
                    for (int n = 0; n < 2; ++n) acc[a][b][m][n] = (f32x4){0.f, 0.f, 0.f, 0.f};
        }
        cur = nxt; cA = nA; cB = nB; ++ui;
        if (wr == 1) PG8_BAR;
    }
    PG8_WAIT_V(0);
    PG8_BAR;
#undef PG8_SA
#undef PG8_SB
#undef PG8_STAGE
#undef PG8_LDA
#undef PG8_LDB
#undef PG8_MMA
#undef PG8_WAIT_V
#undef PG8_WAIT_L
#undef PG8_BAR
#undef PG8_SCHED
}
}

struct SrcPlain { const char* A; const char* B; size_t tstep;
    __device__ __forceinline__ const char* a(const pg8::Unit& u) const { return A + (size_t)u.pm * tstep; }
    __device__ __forceinline__ const char* b(const pg8::Unit& u) const { return B + (size_t)u.pn * tstep; } };
struct SrcP2 { const char *A0, *A1, *B0, *B1; size_t tstep;
    __device__ __forceinline__ const char* a(const pg8::Unit& u) const { return (u.pn < 6 ? A0 : A1) + (size_t)u.pm * tstep; }
    __device__ __forceinline__ const char* b(const pg8::Unit& u) const { return u.pn < 6 ? B0 + (size_t)u.pn * tstep : B1 + (size_t)(u.pn - 6) * tstep; } };

__device__ __forceinline__ float fq_sum(float v) { v += __shfl_xor(v, 16); v += __shfl_xor(v, 32); return v; }
struct EpiP1 {
    static constexpr bool PERM = true; static __device__ __forceinline__ bool keep(const pg8::Unit&) { return false; }
    Frame F;
    __device__ __forceinline__ void operator()(f32x4 (&acc)[2][2][4][2], const pg8::Unit& u, int wr, int wc, int fr, int fq) const {
        const int pn = u.pn, row0 = u.pm * 256 + wr * 64 + fr, c8 = 32 * wc + 8 * fq;
        const float* rstd = W_RSTDX(F);
        if (pn < 16 || (pn >= 20 && pn < 24)) {
            bf16* dst; int cb; bool act = false;
            if (pn < 4) { dst = W_AQ(F); cb = pn * 256; } else if (pn < 8) { dst = W_AK(F); cb = (pn - 4) * 256; } else if (pn < 12) { dst = W_AV(F); cb = (pn - 8) * 256; }
            else if (pn < 16) { dst = W_AGS(F); cb = (pn - 12) * 256; act = true; } else { dst = W_BGS(F); cb = (pn - 20) * 256; act = true; }
#pragma unroll
            for (int ai = 0; ai < 2; ++ai)
#pragma unroll
                for (int m = 0; m < 4; ++m) { const int row = row0 + ai * 128 + m * 16; const float rs = rstd[row]; bf16* rowp = dst + (size_t)row * 1024 + cb + c8;
#pragma unroll
                    for (int bj = 0; bj < 2; ++bj) { f32x4 v0 = acc[ai][bj][m][0] * rs, v1 = acc[ai][bj][m][1] * rs;
                        if (act) {
#pragma unroll
                            for (int e = 0; e < 4; ++e) { v0[e] = silu_f(v0[e]); v1[e] = silu_f(v1[e]); } }
                        *(u32x4*)(rowp + bj * 128) = pg8::pack8(v0, v1); } }
        } else if (pn < 20) {
            bf16* dst = pn < 18 ? W_CQ(F) : W_CKV(F); float* ssq = pn < 18 ? W_SSQQ(F) : W_SSQKV(F); const int cb = (pn & 1) * 256;
#pragma unroll
            for (int ai = 0; ai < 2; ++ai)
#pragma unroll
                for (int m = 0; m < 4; ++m) { const int row = row0 + ai * 128 + m * 16; const float rs = rstd[row]; bf16* rowp = dst + (size_t)row * 512 + cb + c8; float s = 0.f;
#pragma unroll
                    for (int bj = 0; bj < 2; ++bj) { const f32x4 v0 = acc[ai][bj][m][0] * rs, v1 = acc[ai][bj][m][1] * rs;
                        s += (v0[0] * v0[0] + v0[1] * v0[1]) + (v0[2] * v0[2] + v0[3] * v0[3]) + (v1[0] * v1[0] + v1[1] * v1[1]) + (v1[2] * v1[2] + v1[3] * v1[3]);
                        *(u32x4*)(rowp + bj * 128) = pg8::pack8(v0, v1); }
                    s = fq_sum(s);
                    if (fq == 0) ssq[(size_t)row * 8 + (pn & 1) * 4 + wc] = s; }
        } else if (pn < 40) {
            bf16* Rp = W_R(F); bf16* Sp = W_SB(F); const int cb = (pn - 24) * 128 + c8;
#pragma unroll
            for (int ai = 0; ai < 2; ++ai)
#pragma unroll
                for (int m = 0; m < 4; ++m) { const int row = row0 + ai * 128 + m * 16; const float rs = rstd[row]; f32x4 r0, r1, s0, s1;
#pragma unroll
                    for (int e = 0; e < 4; ++e) { const float sa0 = sigm_f(acc[ai][0][m][0][e] * rs), sb0 = sigm_f(acc[ai][1][m][0][e] * rs), sa1 = sigm_f(acc[ai][0][m][1][e] * rs), sb1 = sigm_f(acc[ai][1][m][1][e] * rs);
                        r0[e] = sa0 / sb0; s0[e] = sb0; r1[e] = sa1 / sb1; s1[e] = sb1; }
                    *(u32x4*)(Rp + (size_t)row * 2048 + cb) = pg8::pack8(r0, r1); *(u32x4*)(Sp + (size_t)row * 2048 + cb) = pg8::pack8(s0, s1); }
        } else if (wc == 0) {
            bf16* kr = W_KR(F); const f32x2* cs = W_CS(F);
#pragma unroll
            for (int ai = 0; ai < 2; ++ai)
#pragma unroll
                for (int m = 0; m < 4; ++m) { const int row = row0 + ai * 128 + m * 16; const float rs = rstd[row]; const f32x4* cp = (const f32x4*)(cs + (size_t)row * 32 + 8 * fq); f32x4 a0, a1, b0, b1;
#pragma unroll
                    for (int n = 0; n < 2; ++n) { const f32x4 x1 = acc[ai][0][m][n] * rs, x2 = acc[ai][1][m][n] * rs; const f32x4 c01 = cp[2 * n], c23 = cp[2 * n + 1];
                        f32x4 o1, o2;
                        o1[0] = x1[0] * c01[0] - x2[0] * c01[1]; o2[0] = x1[0] * c01[1] + x2[0] * c01[0]; o1[1] = x1[1] * c01[2] - x2[1] * c01[3]; o2[1] = x1[1] * c01[3] + x2[1] * c01[2];
                        o1[2] = x1[2] * c23[0] - x2[2] * c23[1]; o2[2] = x1[2] * c23[1] + x2[2] * c23[0]; o1[3] = x1[3] * c23[2] - x2[3] * c23[3]; o2[3] = x1[3] * c23[3] + x2[3] * c23[2];
                        if (n == 0) { a0 = o1; b0 = o2; } else { a1 = o1; b1 = o2; } }
                    *(u32x4*)(kr + (size_t)row * 64 + 8 * fq) = pg8::pack8(a0, a1); *(u32x4*)(kr + (size_t)row * 64 + 32 + 8 * fq) = pg8::pack8(b0, b1); }
        }
    }
};
struct EpiP2 {
    static constexpr bool PERM = true; static __device__ __forceinline__ bool keep(const pg8::Unit&) { return false; }
    Frame F;
    __device__ __forceinline__ void operator()(f32x4 (&acc)[2][2][4][2], const pg8::Unit& u, int wr, int wc, int fr, int fq) const {
        const int pn = u.pn, row0 = u.pm * 256 + wr * 64 + fr, c8 = 32 * wc + 8 * fq;
        if (pn < 4) {
            bf16* q = W_Q(F); const float* ssq = W_SSQQ(F);
#pragma unroll
            for (int ai = 0; ai < 2; ++ai)
#pragma unroll
                for (int m = 0; m < 4; ++m) { const int row = row0 + ai * 128 + m * 16; const float rs = rstd8(ssq + (size_t)row * 8, 1.f / 512.f, NORM_EPS);
#pragma unroll
                    for (int bj = 0; bj < 2; ++bj) *(u32x4*)(q + (size_t)row * NQ + (2 * pn + bj) * 192 + c8) = pg8::pack8(acc[ai][bj][m][0] * rs, acc[ai][bj][m][1] * rs); }
        } else if (pn < 6) {
            bf16* q = W_Q(F); const float* ssq = W_SSQQ(F); const f32x2* cs = W_CS(F); const int head = 4 * (pn - 4) + wc;
#pragma unroll
            for (int ai = 0; ai < 2; ++ai)
#pragma unroll
                for (int m = 0; m < 4; ++m) { const int row = row0 + ai * 128 + m * 16; const float rs = rstd8(ssq + (size_t)row * 8, 1.f / 512.f, NORM_EPS); const f32x4* cp = (const f32x4*)(cs + (size_t)row * 32 + 8 * fq); f32x4 a0, a1, b0, b1;
#pragma unroll
                    for (int n = 0; n < 2; ++n) { const f32x4 x1 = acc[ai][0][m][n] * rs, x2 = acc[ai][1][m][n] * rs; const f32x4 c01 = cp[2 * n], c23 = cp[2 * n + 1];
                        f32x4 o1, o2;
                        o1[0] = x1[0] * c01[0] - x2[0] * c01[1]; o2[0] = x1[0] * c01[1] + x2[0] * c01[0]; o1[1] = x1[1] * c01[2] - x2[1] * c01[3]; o2[1] = x1[1] * c01[3] + x2[1] * c01[2];
                        o1[2] = x1[2] * c23[0] - x2[2] * c23[1]; o2[2] = x1[2] * c23[1] + x2[2] * c23[0]; o1[3] = x1[3] * c23[2] - x2[3] * c23[3]; o2[3] = x1[3] * c23[3] + x2[3] * c23[2];
                        if (n == 0) { a0 = o1; b0 = o2; } else { a1 = o1; b1 = o2; } }
                    *(u32x4*)(q + (size_t)row * NQ + head * 192 + 128 + 8 * fq) = pg8::pack8(a0, a1); *(u32x4*)(q + (size_t)row * NQ + head * 192 + 160 + 8 * fq) = pg8::pack8(b0, b1); }
        } else {
            bf16* kv = W_KV(F); const float* ssq = W_SSQKV(F);
#pragma unroll
            for (int ai = 0; ai < 2; ++ai)
#pragma unroll
                for (int m = 0; m < 4; ++m) { const int row = row0 + ai * 128 + m * 16; const float rs = rstd8(ssq + (size_t)row * 8, 1.f / 512.f, NORM_EPS);
#pragma unroll
                    for (int bj = 0; bj < 2; ++bj) *(u32x4*)(kv + (size_t)row * NKV + (pn - 6) * 256 + bj * 128 + c8) = pg8::pack8(acc[ai][bj][m][0] * rs, acc[ai][bj][m][1] * rs); }
        }
    }
};
struct EpiP4 {
    static constexpr bool PERM = true; static __device__ __forceinline__ bool keep(const pg8::Unit& u) { return u.part == 0; }
    Frame F;
    __device__ __forceinline__ void operator()(f32x4 (&acc)[2][2][4][2], const pg8::Unit& u, int wr, int wc, int fr, int fq) const {
        const size_t o0 = (size_t)(u.pm * 256 + wr * 64 + fr) * 2048 + u.pn * 256 + 32 * wc + 8 * fq;
        if (u.part == 0) {
            const bf16* Rp = W_R(F);
#pragma unroll
            for (int ai = 0; ai < 2; ++ai)
#pragma unroll
                for (int m = 0; m < 4; ++m) {
#pragma unroll
                    for (int bj = 0; bj < 2; ++bj) { const u32x4 w = *(const u32x4*)(Rp + o0 + (size_t)(ai * 128 + m * 16) * 2048 + bj * 128); f32x4 r0, r1; pg8::unpack8(w, r0, r1); acc[ai][bj][m][0] *= r0; acc[ai][bj][m][1] *= r1; }
                    if (m & 1) asm volatile("" ::: "memory"); }
        } else {
            const bf16* Sp = W_SB(F); bf16* Mp = W_MERGED(F);
#pragma unroll
            for (int ai = 0; ai < 2; ++ai)
#pragma unroll
                for (int m = 0; m < 4; ++m) {
#pragma unroll
                    for (int bj = 0; bj < 2; ++bj) { const size_t o = o0 + (size_t)(ai * 128 + m * 16) * 2048 + bj * 128; const u32x4 w = *(const u32x4*)(Sp + o); f32x4 s0, s1; pg8::unpack8(w, s0, s1);
                        *(u32x4*)(Mp + o) = pg8::pack8(acc[ai][bj][m][0] * s0, acc[ai][bj][m][1] * s1); }
                    if (m & 1) asm volatile("" ::: "memory"); }
        }
    }
};
struct OrderP4 { pg8::StaticOrder S;
    __device__ bool next(int i, pg8::Unit& u) const { if (!S.next(i >> 1, u)) return false; u.part = i & 1; return true; } };
struct SrcP4 { const char* A; const char* B; size_t tstep;
    __device__ __forceinline__ const char* a(const pg8::Unit& u) const { return A + (size_t)u.pm * tstep + (size_t)u.part * 2048; }
    __device__ __forceinline__ const char* b(const pg8::Unit& u) const { return B + (size_t)u.pn * tstep + (size_t)u.part * 2048; } };
struct EpiP5 {
    static constexpr bool PERM = false; static __device__ __forceinline__ bool keep(const pg8::Unit&) { return false; }
    Frame F;
    __device__ __forceinline__ void operator()(f32x4 (&acc)[2][2][4][2], const pg8::Unit& u, int wr, int wc, int fr, int fq) const {
        const int row0 = u.pm * 256 + wr * 64 + fr, col0 = u.pn * 256 + wc * 32 + 4 * fq; const float* x = IN_X(F); float* out = F.out; float* rowss = W_ROWSS(F);
#pragma unroll
        for (int ai = 0; ai < 2; ++ai)
#pragma unroll
            for (int m = 0; m < 4; ++m) { const int row = row0 + ai * 128 + m * 16; const size_t o = (size_t)row * DM + col0; float s = 0.f;
#pragma unroll
                for (int bj = 0; bj < 2; ++bj)
#pragma unroll
                    for (int n = 0; n < 2; ++n) { const f32x4 y = *(const f32x4*)(x + o + bj * 128 + n * 16) + acc[ai][bj][m][n]; *(f32x4*)(out + o + bj * 128 + n * 16) = y; s += (y[0] * y[0] + y[1] * y[1]) + (y[2] * y[2] + y[3] * y[3]); }
                s = fq_sum(s);
                if (fq == 0) rowss[(size_t)row * 32 + u.pn * 4 + wc] = s; }
    }
};

namespace att {
typedef float f32x16 __attribute__((ext_vector_type(16)));
typedef short s16x4 __attribute__((ext_vector_type(4)));
constexpr int SHM_V = 16384, KBUF = 24576, OFF_K = 2 * SHM_V, OFF_KR = 16384, OFF_WS = OFF_K + 2 * KBUF, OFF_KPOS = OFF_WS + 2048, ATT_LDS = OFF_KPOS + 65536;
constexpr float THR = 8.f;
#define SBAR() __builtin_amdgcn_sched_barrier(0)
__device__ __forceinline__ int crow(int r, int hi) { return (r & 3) + 8 * (r >> 2) + 4 * hi; }
__device__ __forceinline__ unsigned cvtpk(float lo, float hi) { unsigned r; asm volatile("v_cvt_pk_bf16_f32 %0, %1, %2" : "=v"(r) : "v"(lo), "v"(hi)); return r; }
template <int MODE> __device__ __forceinline__ void partialSM(f32x16& p0, f32x16& p1, float& m_reg, float& mn, float& alpha, float qpos, float nslope, const LAS float* kp) {
  constexpr float SCALE = MODE == 0 ? 0.125f : 0.07216878364870322f, C = SCALE * 1.4426950408889634f;
  if (MODE == 0) {
#pragma unroll
    for (int g = 0; g < 4; ++g) { const f32x4 ka = *(const LAS f32x4*)(kp + 8 * g), kb = *(const LAS f32x4*)(kp + 32 + 8 * g);
#pragma unroll
      for (int e = 0; e < 4; ++e) { p0[4 * g + e] = fmaf(nslope, fabsf(qpos - ka[e]), p0[4 * g + e]); p1[4 * g + e] = fmaf(nslope, fabsf(qpos - kb[e]), p1[4 * g + e]); } }
  }
  float pmax = p0[0];
#pragma unroll
  for (int r = 1; r < 16; ++r) pmax = fmaxf(pmax, p0[r]);
#pragma unroll
  for (int r = 0; r < 16; ++r) pmax = fmaxf(pmax, p1[r]);
  { auto rr = __builtin_amdgcn_permlane32_swap(__float_as_uint(pmax), __float_as_uint(pmax), false, false);
    pmax = fmaxf(__uint_as_float(rr[0]), __uint_as_float(rr[1])); }
  if (__builtin_expect(__all(pmax - m_reg <= THR / SCALE), 1)) { mn = m_reg; alpha = 1.f; }
  else { mn = fmaxf(m_reg, pmax); alpha = __builtin_amdgcn_exp2f((m_reg - mn) * C); m_reg = mn; }
  const float mnC = -mn * C;
#pragma unroll
  for (int r = 0; r < 16; ++r) p0[r] = fmaf(p0[r], C, mnC);
#pragma unroll
  for (int r = 0; r < 16; ++r) p1[r] = fmaf(p1[r], C, mnC);
#pragma unroll
  for (int r = 0; r < 16; ++r) p0[r] = __builtin_amdgcn_exp2f(p0[r]);
}
__device__ __forceinline__ void finishSM(f32x16& p0, f32x16& p1, float alpha, float& l_reg, bf16x8& pa0, bf16x8& pa1, bf16x8& pa2, bf16x8& pa3) {
#pragma unroll
  for (int r = 0; r < 16; ++r) p1[r] = __builtin_amdgcn_exp2f(p1[r]);
  float ps = 0;
#pragma unroll
  for (int r = 0; r < 16; ++r) ps += p0[r];
#pragma unroll
  for (int r = 0; r < 16; ++r) ps += p1[r];
  { auto rr = __builtin_amdgcn_permlane32_swap(__float_as_uint(ps), __float_as_uint(ps), false, false);
    ps = __uint_as_float(rr[0]) + __uint_as_float(rr[1]); }
  l_reg = l_reg * alpha + ps;
#define PK4(P, BASE, OUT) do { unsigned a0 = cvtpk(P[BASE + 0], P[BASE + 1]), a1 = cvtpk(P[BASE + 2], P[BASE + 3]);   \
    unsigned b0 = cvtpk(P[BASE + 4], P[BASE + 5]), b1 = cvtpk(P[BASE + 6], P[BASE + 7]);                              \
    auto r0 = __builtin_amdgcn_permlane32_swap(a0, b0, false, false); auto r1 = __builtin_amdgcn_permlane32_swap(a1, b1, false, false); \
    u32x4 w = {r0[0], r1[0], r0[1], r1[1]}; OUT = __builtin_bit_cast(bf16x8, w); } while (0)
  PK4(p0, 0, pa0); PK4(p0, 8, pa1); PK4(p1, 0, pa2); PK4(p1, 8, pa3);
#undef PK4
}
#ifndef ATT_NQL
#define ATT_NQL 4
#endif
constexpr int NQL = ATT_NQL;
constexpr int OFF_QL = OFF_WS + 2048;
#define QFRAG(d) ((d) < 12 - NQL ? qr[(d)] : *(const LAS bf16x8*)(ql + ((d) - (12 - NQL)) * 1024))
template <int MODE> __device__ __forceinline__ void qkt(f32x16& p0, f32x16& p1, const LAS unsigned char* Kb, const bf16x8* qr, const LAS unsigned char* ql, int r32, int hi) {
  p0 = f32x16{}; p1 = f32x16{};
  if (MODE == 0) {
#pragma unroll
    for (int d0 = 0; d0 < 4; ++d0) { const int off = r32 * 128 + (((d0 * 2 + hi) ^ ((r32 >> 1) & 7)) << 4);
      const bf16x8 b0 = *(const LAS bf16x8*)(Kb + off), b1 = *(const LAS bf16x8*)(Kb + off + 4096);
      p0 = __builtin_amdgcn_mfma_f32_32x32x16_bf16(b0, qr[d0], p0, 0, 0, 0); p1 = __builtin_amdgcn_mfma_f32_32x32x16_bf16(b1, qr[d0], p1, 0, 0, 0); }
  } else {
#pragma unroll
    for (int d0 = 0; d0 < 8; ++d0) { const int off = r32 * 256 + (((d0 * 2 + hi) ^ (r32 & 15)) << 4);
      const bf16x8 b0 = *(const LAS bf16x8*)(Kb + off), b1 = *(const LAS bf16x8*)(Kb + off + 8192);
      const bf16x8 qf = QFRAG(d0); p0 = __builtin_amdgcn_mfma_f32_32x32x16_bf16(b0, qf, p0, 0, 0, 0); p1 = __builtin_amdgcn_mfma_f32_32x32x16_bf16(b1, qf, p1, 0, 0, 0); }
#pragma unroll
    for (int d0 = 0; d0 < 4; ++d0) { const int off = OFF_KR + r32 * 128 + (((d0 * 2 + hi) ^ ((r32 >> 1) & 7)) << 4);
      const bf16x8 b0 = *(const LAS bf16x8*)(Kb + off), b1 = *(const LAS bf16x8*)(Kb + off + 4096);
      const bf16x8 qf = QFRAG(8 + d0); p0 = __builtin_amdgcn_mfma_f32_32x32x16_bf16(b0, qf, p0, 0, 0, 0); p1 = __builtin_amdgcn_mfma_f32_32x32x16_bf16(b1, qf, p1, 0, 0, 0); }
  }
}
__device__ __forceinline__ int v_st(int k, int c) { const int kk = (k & ~0xC) | ((k & 4) << 1) | ((k & 8) >> 1); return ((kk >> 3) * 4 + (c >> 5)) * 512 + ((kk & 7) * 32 + (c & 31)) * 2; }
__device__ __forceinline__ int v_rd_base(int lane) { return ((lane & 3) << 3) | (((lane >> 2) & 3) << 6) | (((lane >> 4) & 1) << 5) | (((lane >> 5) & 1) << 8); }
constexpr int v_rd_off(int d0, int ks, int half) { return d0 * 512 + ks * 4096 + half * 2048; }
template <int OFF> __device__ __forceinline__ s16x4 tr_read(int vb) { s16x4 r; asm volatile("ds_read_b64_tr_b16 %0, %1 offset:%2" : "=&v"(r) : "v"(vb), "i"(OFF) : "memory"); return r; }
template <int D0> __device__ __forceinline__ void pv_one(f32x16& od, int vb, bf16x8 pa0, bf16x8 pa1, bf16x8 pa2, bf16x8 pa3) {
  const s16x4 l0 = tr_read<v_rd_off(D0, 0, 0)>(vb), h0 = tr_read<v_rd_off(D0, 0, 1)>(vb), l1 = tr_read<v_rd_off(D0, 1, 0)>(vb), h1 = tr_read<v_rd_off(D0, 1, 1)>(vb);
  const s16x4 l2 = tr_read<v_rd_off(D0, 2, 0)>(vb), h2 = tr_read<v_rd_off(D0, 2, 1)>(vb), l3 = tr_read<v_rd_off(D0, 3, 0)>(vb), h3 = tr_read<v_rd_off(D0, 3, 1)>(vb);
  asm volatile("s_waitcnt lgkmcnt(0)" ::: "memory"); SBAR();
#define PK(L, H) (bf16x8){L[0], L[1], L[2], L[3], H[0], H[1], H[2], H[3]}
  od = __builtin_amdgcn_mfma_f32_32x32x16_bf16(pa0, PK(l0, h0), od, 0, 0, 0);
  od = __builtin_amdgcn_mfma_f32_32x32x16_bf16(pa1, PK(l1, h1), od, 0, 0, 0);
  od = __builtin_amdgcn_mfma_f32_32x32x16_bf16(pa2, PK(l2, h2), od, 0, 0, 0);
  od = __builtin_amdgcn_mfma_f32_32x32x16_bf16(pa3, PK(l3, h3), od, 0, 0, 0);
#undef PK
}
__device__ __forceinline__ void pv_d0(f32x16* o, int vb, bf16x8 pa0, bf16x8 pa1, bf16x8 pa2, bf16x8 pa3) {
  pv_one<0>(o[0], vb, pa0, pa1, pa2, pa3); pv_one<1>(o[1], vb, pa0, pa1, pa2, pa3); pv_one<2>(o[2], vb, pa0, pa1, pa2, pa3); pv_one<3>(o[3], vb, pa0, pa1, pa2, pa3);
}
template <int MODE, int SDEPTH>
__device__ __forceinline__ void attn_core(f32x16 (&o)[4], const bf16* __restrict__ Qw, const bf16* __restrict__ K1, const bf16* __restrict__ K2, const bf16* __restrict__ Vh,
                                          float qpos, float nslope, LAS unsigned char* lds) {
  constexpr int DQ = MODE == 0 ? 4 : 12, LDK1 = MODE == 0 ? 1024 : 2048, LDV = MODE == 0 ? 1024 : 2048, NLD = MODE == 0 ? 3 : 5;
  const int wid = __builtin_amdgcn_readfirstlane((int)threadIdx.x >> 6), lane = lane_id(), tid = wid * 64 + lane, r32 = lane & 31, hi = lane >> 5;
  LAS unsigned char* V_lds = lds; LAS unsigned char* K_lds = lds + OFF_K;
  LAS float* ws = (LAS float*)(lds + OFF_WS) + wid * 64; LAS float* li_l = ws; LAS float* al_l = ws + 32;
  const LAS float* kpl = (const LAS float*)(lds + OFF_KPOS) + 4 * hi;
  constexpr int DQR = MODE == 0 ? 4 : 12 - NQL;
  float m_reg = -1e30f, l_reg = 0; o[0] = f32x16{}; o[1] = f32x16{}; o[2] = f32x16{}; o[3] = f32x16{}; bf16x8 qr[DQR];
#pragma unroll
  for (int d0 = 0; d0 < DQR; ++d0) qr[d0] = *(const bf16x8*)(Qw + d0 * 16);
  const LAS unsigned char* ql = lds + OFF_QL + wid * (NQL * 1024) + lane * 16;
  if (MODE == 1) {
#pragma unroll
    for (int d0 = DQR; d0 < DQ; ++d0) *(LAS bf16x8*)(lds + OFF_QL + wid * (NQL * 1024) + lane * 16 + (d0 - DQR) * 1024) = *(const bf16x8*)(Qw + d0 * 16);
  }
  const int sr = tid >> 4, sc = (tid & 15) * 8, vst0 = v_st(sr, sc), vst1 = v_st(32 + sr, sc);
  const int kn0 = sr * 256 + (((tid & 15) ^ (sr & 15)) << 4), kn1 = kn0 + 32 * 256;
  const int kr_row = tid >> 3, kr_ch = tid & 7, krw = kr_row * 128 + ((kr_ch ^ ((kr_row >> 1) & 7)) << 4);
  const int vb0 = (int)(unsigned)(uintptr_t)V_lds + v_rd_base(lane);
  struct { bf16x8 vs0, vs1, k0, k1, k2; } sr_[SDEPTH];
  const unsigned voV = (unsigned)(sr * LDV + sc) * 2u, voK = MODE == 0 ? (unsigned)(kr_row * LDK1 + kr_ch * 8) * 2u : voV, voR = (unsigned)(kr_row * 64 + kr_ch * 8) * 2u;
  const char* Vb0 = (const char*)Vh; const char* Vb1 = Vb0 + (size_t)32 * LDV * 2; const char* Kb0 = (const char*)K1; const char* Kb1 = Kb0 + (size_t)32 * LDK1 * 2; const char* Rb0 = (const char*)K2;
#define SLOAD(i, kb) do { const size_t tv_ = (size_t)(kb) * LDV * 2, tk_ = (size_t)(kb) * LDK1 * 2; \
    sr_[i].vs0 = *(const bf16x8*)(Vb0 + tv_ + voV); sr_[i].vs1 = *(const bf16x8*)(Vb1 + tv_ + voV); \
    if (MODE == 0) { sr_[i].k0 = *(const bf16x8*)(Kb0 + tk_ + voK); } \
    else { sr_[i].k0 = *(const bf16x8*)(Kb0 + tk_ + voK); sr_[i].k1 = *(const bf16x8*)(Kb1 + tk_ + voK); sr_[i].k2 = *(const bf16x8*)(Rb0 + (size_t)(kb) * 128 + voR); } } while (0)
#define SWRITE(b, i) do { *(LAS bf16x8*)(V_lds + (b) * SHM_V + vst0) = sr_[i].vs0; *(LAS bf16x8*)(V_lds + (b) * SHM_V + vst1) = sr_[i].vs1; \
    if (MODE == 0) { *(LAS bf16x8*)(K_lds + (b) * KBUF + krw) = sr_[i].k0; } \
    else { *(LAS bf16x8*)(K_lds + (b) * KBUF + kn0) = sr_[i].k0; *(LAS bf16x8*)(K_lds + (b) * KBUF + kn1) = sr_[i].k1; *(LAS bf16x8*)(K_lds + (b) * KBUF + OFF_KR + krw) = sr_[i].k2; } } while (0)
#define SWAIT() do { if constexpr (SDEPTH == 2) { if (MODE == 0) asm volatile("s_waitcnt vmcnt(3)" ::: "memory"); else asm volatile("s_waitcnt vmcnt(5)" ::: "memory"); } else asm volatile("s_waitcnt vmcnt(0)" ::: "memory"); } while (0)
#define RESC(a) do { if (__any((a) < 1.f)) { if (hi == 0) al_l[r32] = (a); asm volatile("s_waitcnt lgkmcnt(0)" ::: "memory"); \
    _Pragma("unroll") for (int d = 0; d < 4; ++d) _Pragma("unroll") for (int r = 0; r < 16; ++r) o[d][r] *= al_l[crow(r, hi)]; } } while (0)
  f32x16 pA0, pA1, pB0, pB1; float mnA, mnB, alA, alB; bf16x8 pa0, pa1, pa2, pa3; constexpr int NT = SEQ / 64;
  constexpr int SE = 0, SO = SDEPTH - 1;
  (void)NLD;
  SLOAD(SE, 0); asm volatile("s_waitcnt vmcnt(0)" ::: "memory"); SWRITE(0, SE); __syncthreads();
  qkt<MODE>(pA0, pA1, K_lds, qr, ql, r32, hi); partialSM<MODE>(pA0, pA1, m_reg, mnA, alA, qpos, nslope, kpl);
  SLOAD(SO, 64); if constexpr (SDEPTH == 2) { SLOAD(SE, 2 * 64); }
  SWAIT(); SWRITE(1, SO); __syncthreads();
#pragma unroll 1
  for (int j = 1; j + 1 < NT; j += 2) {
    SBAR(); qkt<MODE>(pB0, pB1, K_lds + KBUF, qr, ql, r32, hi);
    finishSM(pA0, pA1, alA, l_reg, pa0, pa1, pa2, pa3); SBAR();
    SLOAD(SO, (j + SDEPTH) * 64); SBAR();
    pv_d0(o, vb0, pa0, pa1, pa2, pa3); partialSM<MODE>(pB0, pB1, m_reg, mnB, alB, qpos, nslope, kpl + j * 64);
    __syncthreads(); SWAIT(); SWRITE(0, SE);
    RESC(alB); __syncthreads();
    SBAR(); qkt<MODE>(pA0, pA1, K_lds, qr, ql, r32, hi);
    finishSM(pB0, pB1, alB, l_reg, pa0, pa1, pa2, pa3); SBAR();
    if (SDEPTH == 1 || j + 3 < NT) SLOAD(SE, (j + 1 + SDEPTH) * 64); SBAR();
    pv_d0(o, vb0 + SHM_V, pa0, pa1, pa2, pa3); partialSM<MODE>(pA0, pA1, m_reg, mnA, alA, qpos, nslope, kpl + (j + 1) * 64);
    __syncthreads(); SWAIT(); SWRITE(1, SO);
    RESC(alA); __syncthreads();
  }
  SBAR(); qkt<MODE>(pB0, pB1, K_lds + KBUF, qr, ql, r32, hi);
  finishSM(pA0, pA1, alA, l_reg, pa0, pa1, pa2, pa3); SBAR();
  pv_d0(o, vb0, pa0, pa1, pa2, pa3); partialSM<MODE>(pB0, pB1, m_reg, mnB, alB, qpos, nslope, kpl + (NT - 1) * 64);
  __syncthreads(); RESC(alB);
  finishSM(pB0, pB1, alB, l_reg, pa0, pa1, pa2, pa3); SBAR();
  pv_d0(o, vb0 + SHM_V, pa0, pa1, pa2, pa3);
  if (hi == 0) li_l[r32] = l_reg; asm volatile("s_waitcnt lgkmcnt(0)" ::: "memory");
#pragma unroll
  for (int r = 0; r < 16; ++r) { const float rl = __builtin_amdgcn_rcpf(li_l[crow(r, hi)]);
#pragma unroll
    for (int d0 = 0; d0 < 4; ++d0) o[d0][r] *= rl; }
#undef SLOAD
#undef SWRITE
#undef SWAIT
#undef RESC
}
#undef SBAR
}

#ifndef ATT_SDEPTH0
#define ATT_SDEPTH0 2
#endif
#ifndef ATT_SDEPTH1
#define ATT_SDEPTH1 1
#endif
__device__ __forceinline__ void p3_fast(Frame& F) {
    using att::f32x16; using att::crow;
    LAS unsigned char* lds = F.lds;
    const int wid = F.wave;
    const float lam = lambda_full(F);
#ifndef ATT_SKIP_A
    const int nUA = (512 - F.vcu + F.G - 1) / F.G;
#pragma unroll 1
    for (int v = 0; v < 2 * nUA; ++v) {
        const int u = F.vcu + (v >> 1) * F.G, map = v & 1;
        const int bh = u >> 4, qb = u & 15, b = bh >> 3, h = bh & 7; const size_t tok0 = (size_t)b * SEQ; const int q0 = qb * 256;
        const int lane = lane_id(), tid = wid * 64 + lane, r32 = lane & 31, hi = lane >> 5;
        __syncthreads();
        if (map == 0) { LAS float* kp = (LAS float*)(lds + att::OFF_KPOS); const int* ps = IN_POS(F) + tok0; for (int i = tid; i < SEQ; i += NWAVES * 64) kp[i] = (float)ps[i]; }
        const int qrow = q0 + wid * 32 + r32; const float qpos = (float)IN_POS(F)[tok0 + qrow]; const float nslope = -exp2f(-(float)(h + 1)) * 8.0f;
        const bf16* Qw = W_AQ(F) + (tok0 + qrow) * 1024 + h * 128 + map * 64 + hi * 8;
        const bf16* Kh = W_AK(F) + tok0 * 1024 + h * 128 + map * 64; const bf16* Vh = W_AV(F) + tok0 * 1024 + h * 128;
        f32x16 o[4];
        att::attn_core<0, ATT_SDEPTH0>(o, Qw, Kh, nullptr, Vh, qpos, nslope, lds);
        float* stash = W_STASH(F) + ((size_t)blockIdx.x * 512 + tid) * 64;
        if (map == 0) {
#pragma unroll
            for (int d0 = 0; d0 < 4; ++d0)
#pragma unroll
                for (int g = 0; g < 4; ++g) *(f32x4*)(stash + d0 * 16 + 4 * g) = (f32x4){o[d0][4 * g], o[d0][4 * g + 1], o[d0][4 * g + 2], o[d0][4 * g + 3]};
        } else {
            int rb = q0 + wid * 32 + 4 * hi; asm volatile("" : "+v"(rb));
#pragma unroll
            for (int d0 = 0; d0 < 4; ++d0)
#pragma unroll
                for (int g = 0; g < 4; ++g) { const f32x4 t = *(const f32x4*)(stash + d0 * 16 + 4 * g);
#pragma unroll
                    for (int e = 0; e < 4; ++e) o[d0][4 * g + e] = t[e] - lam * o[d0][4 * g + e]; }
            float ss[16];
#pragma unroll
            for (int r = 0; r < 16; ++r) { float s = 0.f;
#pragma unroll
                for (int d0 = 0; d0 < 4; ++d0) s += o[d0][r] * o[d0][r];
                s += __shfl_xor(s, 1); s += __shfl_xor(s, 2); s += __shfl_xor(s, 4); s += __shfl_xor(s, 8); s += __shfl_xor(s, 16); ss[r] = s; }
            const float* sg = IN_SUBLNG(F); const bf16* ags = W_AGS(F); bf16* abin = W_ABIN(F);
            float gcol[4];
#pragma unroll
            for (int d0 = 0; d0 < 4; ++d0) gcol[d0] = sg[d0 * 32 + r32] * (1.f - LAM_INIT);
#pragma unroll
            for (int r = 0; r < 16; ++r) { const float rs = 1.0f / sqrtf(ss[r] * (1.f / 128.f) + SUBLN_EPS); const size_t row = tok0 + rb + (r & 3) + 8 * (r >> 2);
#pragma unroll
                for (int d0 = 0; d0 < 4; ++d0) { const int col = h * 128 + d0 * 32 + r32; abin[row * 2048 + col] = (bf16)f2bf(o[d0][r] * rs * gcol[d0] * bf2f(ags[row * 1024 + col])); } }
        }
    }
#endif
#ifndef ATT_SKIP_B
#pragma unroll 1
    for (int u = F.vcu; u < 512; u += F.G) {
        const int bh = u >> 4, qb = u & 15, b = bh >> 3, h = bh & 7; const size_t tok0 = (size_t)b * SEQ; const int q0 = qb * 256;
        const int lane = lane_id(), r32 = lane & 31, hi = lane >> 5;
        __syncthreads();
        const int qrow = q0 + wid * 32 + r32;
        const bf16* Qw = W_Q(F) + (tok0 + qrow) * NQ + h * 192 + hi * 8;
        const bf16* Kh = W_KV(F) + tok0 * NKV + h * 256; const bf16* Kr = W_KR(F) + tok0 * 64;
        f32x16 o[4];
        att::attn_core<1, ATT_SDEPTH1>(o, Qw, Kh, Kr, Kh + 128, 0.f, 0.f, lds);
        const bf16* bgs = W_BGS(F); bf16* abin = W_ABIN(F);
        int rb = q0 + wid * 32 + 4 * hi; asm volatile("" : "+v"(rb));
#pragma unroll
        for (int r = 0; r < 16; ++r) { const size_t row = tok0 + rb + (r & 3) + 8 * (r >> 2);
#pragma unroll
            for (int d0 = 0; d0 < 4; ++d0) { const int col = h * 128 + d0 * 32 + r32; abin[row * 2048 + 1024 + col] = (bf16)f2bf(o[d0][r] * bf2f(bgs[row * 1024 + col])); } }
    }
#endif
}

__device__ __forceinline__ void p6_final(Frame& F) {
    const int gw = F.vcu * NWAVES + F.wave, NGW = F.G * NWAVES, lane = lane_id();
    for (int m = gw; m < T; m += NGW) {
        float s = lane < 32 ? W_ROWSS(F)[(size_t)m * 32 + lane] : 0.f;
        s = wave_sum(s);
        const float rs = 1.0f / sqrtf(s * (1.f / DM) + NORM_EPS);
        f32x4* yr = (f32x4*)(F.out + (size_t)m * DM) + lane; const f32x4* gr = (const f32x4*)IN_FINALG(F) + lane;
#pragma unroll
        for (int j = 0; j < 8; ++j) { const f32x4 y = yr[64 * j], g = gr[64 * j]; yr[64 * j] = (f32x4){y.x * rs * g.x, y.y * rs * g.y, y.z * rs * g.z, y.w * rs * g.w}; }
    }
}

__global__ void __launch_bounds__(NWAVES * 64, 2) mk_fwd(Args args) {
    extern __shared__ __attribute__((aligned(16))) unsigned char lds[];
    Frame F;
    F.lds = (LAS unsigned char*)lds;
    F.MISC = (volatile LAS unsigned*)(F.lds + MISC_OFF);
    F.wave = __builtin_amdgcn_readfirstlane((int)threadIdx.x >> 6);
    F.G = gridDim.x; { const int bx = blockIdx.x; F.vcu = (F.G % 8 == 0) ? (bx % 8) * (F.G / 8) + bx / 8 : bx; }
    F.in = args.in; F.out = args.out; F.ws = args.ws;
    for (int u = threadIdx.x; u < (LDS_BYTES - LDSCTL_OFF) / 4; u += NWAVES * 64) ((LAS unsigned*)(F.lds + LDSCTL_OFF))[u] = 0u;
    __syncthreads();
    XcdBarrier bar; bar.bar = W_CTL(F) + CW_BAR + args.li * XCD_BAR_WORDS; bar.x = 0; bar.st = nullptr;
    if (MK_N_LAUNCHES != NPHASE) bar = xcd_barrier_post(W_CTL(F) + CW_BAR + args.li * XCD_BAR_WORDS, F.MISC + 8);
#define GRID_BAR() do { if (MK_N_LAUNCHES != NPHASE) xcd_barrier(bar); } while (0)
    const int lo = args.ph_lo, hi = args.ph_hi;
#define IN(k) (lo <= (k) && (k) < hi)
#define BOTH(k) (IN(k) && IN((k) + 1))
    const int gw = F.vcu * NWAVES + F.wave, NGW = F.G * NWAVES;

    if (IN(0)) { p0_prologue(F); if (BOTH(0)) GRID_BAR(); }
    if (IN(1)) {
#if NAIVE_P1
        NEpiP1 e{F}; naive_gemm(W_XB(F), DM, W_WIN(F), DM, T, NP1, DM, e, gw, NGW, lane_id(), 0);
#else
        pg8::StaticOrder S; S.init(T, NP1, F.G, (int)blockIdx.x); SrcPlain P{(const char*)W_XB(F), (const char*)W_WIN(F), (size_t)256 * DM * 2}; EpiP1 E{F};
        pg8::gemm_phase(F.lds, DM, DM / 64, S, P, E);
#endif
        if (BOTH(1)) GRID_BAR();
    }
    if (IN(2)) {
#if NAIVE_P2
        NEpiQ eq{F}; naive_gemm(W_CQ(F), 512, W_WUQ(F), 512, T, NQ, 512, eq, gw, NGW, lane_id(), 0);
        NEpiKV ek{F}; naive_gemm(W_CKV(F), 512, W_WUKV(F), 512, T, NKV, 512, ek, gw, NGW, lane_id(), 0);
#else
        pg8::StaticOrder S; S.init(T, NQ + NKV, F.G, (int)blockIdx.x); SrcP2 P{(const char*)W_CQ(F), (const char*)W_CKV(F), (const char*)W_WUQ(F), (const char*)W_WUKV(F), (size_t)256 * 512 * 2}; EpiP2 E{F};
        pg8::gemm_phase(F.lds, 512, 8, S, P, E);
#endif
        if (BOTH(2)) GRID_BAR();
    }
    if (IN(3)) {
#if NAIVE_P3
        p3_naive(F);
#else
        p3_fast(F);
#endif
        if (BOTH(3)) GRID_BAR();
    }
    if (IN(4)) {
#if NAIVE_P4
        NEpiMerge e{F}; naive_gemm(W_ABIN(F), 2048, W_WOAB(F), 2048, T, DM, 2048, e, gw, NGW, lane_id(), 1024);
#else
        OrderP4 S; S.S.init(T, DM, F.G, (int)blockIdx.x); SrcP4 P{(const char*)W_ABIN(F), (const char*)W_WOAB(F), (size_t)256 * 2048 * 2}; EpiP4 E{F};
        pg8::gemm_phase(F.lds, 2048, 16, S, P, E);
#endif
        if (BOTH(4)) GRID_BAR();
    }
    if (IN(5)) {
#if NAIVE_P5
        NEpiOut e{F}; naive_gemm(W_MERGED(F), 2048, W_WOUT(F), 2048, T, DM, 2048, e, gw, NGW, lane_id(), 0);
#else
        pg8::StaticOrder S; S.init(T, DM, F.G, (int)blockIdx.x); SrcPlain P{(const char*)W_MERGED(F), (const char*)W_WOUT(F), (size_t)256 * 2048 * 2}; EpiP5 E{F};
        pg8::gemm_phase(F.lds, 2048, 32, S, P, E);
#endif
        if (BOTH(5)) GRID_BAR();
    }
    if (IN(6)) p6_final(F);
#undef IN
#undef BOTH
}

extern "C" void kernel_launch(void* const* d_in, const int* in_sizes, int n_in, void* d_out, int out_size, void* d_ws, size_t ws_size, hipStream_t stream) {
    static int grid = 0;
    if (grid == 0) {
        if (n_in != 17 || in_sizes[0] != T * DM || out_size != T * DM || ws_size < WS_END) { fprintf(stderr, "kernel_launch: unexpected shapes (n_in %d, in0 %d, out %d, ws %zu)\n", n_in, n_in > 0 ? in_sizes[0] : -1, out_size, ws_size); grid = -1; return; }
        int dev = 0, cus = 0, per_cu = 0;
        if (hipGetDevice(&dev) != hipSuccess || hipDeviceGetAttribute(&cus, hipDeviceAttributeMultiprocessorCount, dev) != hipSuccess) { grid = -1; return; }
        if (hipFuncSetAttribute((const void*)mk_fwd, hipFuncAttributeMaxDynamicSharedMemorySize, LDS_BYTES) != hipSuccess) { fprintf(stderr, "kernel_launch: hipFuncSetAttribute failed\n"); grid = -1; return; }
        if (hipOccupancyMaxActiveBlocksPerMultiprocessor(&per_cu, (const void*)mk_fwd, NWAVES * 64, LDS_BYTES) != hipSuccess || per_cu < 1) { fprintf(stderr, "kernel_launch: occupancy query reports %d blocks per CU\n", per_cu); }
        (void)hipGetLastError();
        grid = cus;
    }
    if (grid < 0) return;
    if (hipMemsetAsync((char*)d_ws + WS_CTL, 0, CTL_ZERO_BYTES, stream) != hipSuccess) { fprintf(stderr, "kernel_launch: memset failed\n"); return; }
    Args a{};
    for (int i = 0; i < 17; ++i) a.in[i] = d_in[i];
    a.out = (float*)d_out; a.ws = (unsigned char*)d_ws;
    for (int li = 0; li < MK_N_LAUNCHES; ++li) {
        if (MK_N_LAUNCHES == NPHASE) { a.ph_lo = li; a.ph_hi = li + 1; } else { a.ph_lo = li * NPHASE / MK_N_LAUNCHES; a.ph_hi = (li + 1) * NPHASE / MK_N_LAUNCHES; }
        a.li = li;
        hipLaunchKernelGGL(mk_fwd, dim3(grid), dim3(NWAVES * 64), LDS_BYTES, stream, a);
        const hipError_t le = hipPeekAtLastError();
        if (le != hipSuccess) { fprintf(stderr, "kernel_launch: launch %d failed: %s\n", li, hipGetErrorName(le)); break; }
    }
}
```

```cpp
#include <hip/hip_runtime.h>
#include <cstdio>
#include <cstdint>

#define GAS __attribute__((address_space(1)))
#define LAS __attribute__((address_space(3)))
typedef unsigned short bf16;
typedef short bf16x8 __attribute__((ext_vector_type(8)));
typedef float f32x4 __attribute__((ext_vector_type(4)));
typedef float f32x2 __attribute__((ext_vector_type(2)));
typedef unsigned u32x4 __attribute__((ext_vector_type(4)));
typedef unsigned u32x2 __attribute__((ext_vector_type(2)));

#ifndef MK_N_LAUNCHES
#define MK_N_LAUNCHES 1
#endif
#ifndef REP_P0
#define REP_P0 1
#endif
#ifndef REP_P1
#define REP_P1 1
#endif
#ifndef REP_P2
#define REP_P2 1
#endif
#ifndef REP_P3A
#define REP_P3A 1
#endif
#ifndef REP_P3B
#define REP_P3B 1
#endif
#ifndef REP_P4
#define REP_P4 1
#endif
#ifndef REP_P5
#define REP_P5 1
#endif
#ifndef REP_P6
#define REP_P6 1
#endif
#ifndef NAIVE_P1
#define NAIVE_P1 0
#endif
#ifndef NAIVE_P2
#define NAIVE_P2 0
#endif
#ifndef NAIVE_P3
#define NAIVE_P3 0
#endif
#ifndef NAIVE_P4
#define NAIVE_P4 0
#endif
#ifndef NAIVE_P5
#define NAIVE_P5 0
#endif

constexpr int NB = 4, SEQ = 4096, T = NB * SEQ, DM = 2048;
constexpr int IN_COLS = 10304;
constexpr int OFF_AQ = 0, OFF_AK = 1024, OFF_AV = 2048, OFF_AG = 3072, OFF_CQ = 4096, OFF_CKV = 4608, OFF_KR = 5120, OFF_BG = 5184, OFF_MG = 6208;
constexpr int NP1 = 41 * 256;
constexpr int NQ = 1536, NKV = 2048;
constexpr int NWAVES = 8, NPHASE = 7;
constexpr float NORM_EPS = 1e-6f, SUBLN_EPS = 1e-5f, LAM_INIT = 0.2f;

constexpr size_t MiB = 1u << 20;
constexpr size_t WS_CTL = 0, CTL_ZERO_BYTES = 1 * MiB;
constexpr size_t WS_RSTDX = 1 * MiB;
constexpr size_t WS_SSQQ = WS_RSTDX + 256 * 1024;
constexpr size_t WS_SSQKV = WS_SSQQ + 512 * 1024;
constexpr size_t WS_ROWSS = 3 * MiB;
constexpr size_t WS_CS = 5 * MiB;
constexpr size_t WS_WUQ = 9 * MiB;
constexpr size_t WS_WUKV = 11 * MiB;
constexpr size_t WS_WOAB = 13 * MiB;
constexpr size_t WS_WOUT = 21 * MiB;
constexpr size_t WS_KR = 29 * MiB;
constexpr size_t WS_XB = 32 * MiB;
constexpr size_t WS_KV = WS_XB;
constexpr size_t WS_WIN = 96 * MiB;
constexpr size_t WS_Q = WS_WIN;
constexpr size_t WS_AQ = 144 * MiB, WS_AK = 176 * MiB, WS_AV = 208 * MiB;
constexpr size_t WS_MERGED = WS_AQ;
constexpr size_t WS_CQ = 240 * MiB, WS_CKV = 256 * MiB;
constexpr size_t WS_R = 272 * MiB, WS_SB = 336 * MiB;
constexpr size_t WS_STASH = 400 * MiB;
constexpr size_t WS_KRP = WS_STASH;
constexpr size_t WS_END = 432 * MiB;
constexpr size_t DO_ABIN = 0, DO_AGS = 64 * MiB, DO_BGS = 96 * MiB;

constexpr int CW_TMO = 0, CW_CODE = 1, CW_BAR = 4096;

constexpr int RING_BYTES = 131072;
constexpr int LDSCTL_OFF = 150 * 1024, MISC_OFF = LDSCTL_OFF + 320;
constexpr int LDS_BYTES = 154624;

#define RLX_AGENT __ATOMIC_RELAXED, __HIP_MEMORY_SCOPE_AGENT
#define LDS_WAIT() asm volatile("s_waitcnt lgkmcnt(0)" ::: "memory")
#define VM_WAIT() asm volatile("s_waitcnt vmcnt(0)" ::: "memory")
__device__ __forceinline__ unsigned f2bf(float f) { unsigned u = __builtin_bit_cast(unsigned, f); return (u + 0x7fffu + ((u >> 16) & 1u)) >> 16; }
__device__ __forceinline__ unsigned pk2(float lo, float hi) { return f2bf(lo) | (f2bf(hi) << 16); }
__device__ __forceinline__ float bf2f(unsigned short b) { return __builtin_bit_cast(float, (unsigned)b << 16); }
__device__ __forceinline__ float bflo(unsigned w) { return __builtin_bit_cast(float, w << 16); }
__device__ __forceinline__ float bfhi(unsigned w) { return __builtin_bit_cast(float, w & 0xffff0000u); }
__device__ __forceinline__ float silu_f(float v) { return v / (1.f + __expf(-v)); }
__device__ __forceinline__ float sigm_f(float v) { return 1.f / (1.f + __expf(-v)); }
__device__ __forceinline__ int lane_id() { int l; asm volatile("v_mbcnt_lo_u32_b32 %0, -1, 0\n\tv_mbcnt_hi_u32_b32 %0, -1, %0" : "=v"(l)); return l; }
__device__ __forceinline__ float wave_sum(float v) {
#pragma unroll
    for (int o = 1; o < 64; o <<= 1) v += __shfl_xor(v, o);
    return v;
}
__device__ __forceinline__ float wave_max(float v) {
#pragma unroll
    for (int o = 1; o < 64; o <<= 1) v = fmaxf(v, __shfl_xor(v, o));
    return v;
}

#define XB_TMO      128
#define XB_XCNT(j)  (256  + 64 * (j))
#define XB_XSUB(j)  (1280 + 64 * (j))
#define XB_XGEN(j)  (2304 + 64 * (j))
#define XB_TOP      3328
#define XB_TOPGEN   3392
#define XCD_BAR_WORDS 3456
#define XB_SPIN_CAP (1u << 18)
__device__ __forceinline__ unsigned xb_ld(unsigned* p)              { return __hip_atomic_load(p, __ATOMIC_RELAXED, __HIP_MEMORY_SCOPE_AGENT); }
__device__ __forceinline__ unsigned xb_add(unsigned* p, unsigned v) { return __hip_atomic_fetch_add(p, v, __ATOMIC_RELAXED, __HIP_MEMORY_SCOPE_AGENT); }
__device__ __forceinline__ unsigned xb_xcc_id() { return (unsigned)__builtin_amdgcn_s_getreg((3 << 11) | 20) & 0xFu; }
#define XB_SPIN(cond, bar) do { unsigned _sp = 0; while (cond) { __builtin_amdgcn_s_sleep(1); \
    if ((++_sp & 255u) == 0u) { if (xb_ld(&(bar)[XB_TMO])) break; if (_sp > XB_SPIN_CAP) { atomicAdd(&(bar)[XB_TMO], 1u); break; } } } } while (0)
struct XcdBarrier { unsigned* bar; unsigned x; volatile LAS unsigned* st; };
__device__ __forceinline__ XcdBarrier xcd_barrier_post(unsigned* bar, volatile LAS unsigned* st) {
    XcdBarrier b; b.bar = bar; b.x = xb_xcc_id(); b.st = st;
    if (threadIdx.x == 0) (void)xb_add(&bar[XB_XCNT(b.x)], 1u);
    return b;
}
__device__ __forceinline__ void xcd_barrier_complete(unsigned* bar, unsigned x, unsigned& nloc, unsigned& nx) {
    const unsigned G = gridDim.x * gridDim.y * gridDim.z;
    unsigned sum, cnt, mine, sp = 0u;
    for (;;) {
        sum = 0u; cnt = 0u; mine = 0u;
#pragma unroll
        for (unsigned j = 0; j < 16; ++j) { const unsigned c = xb_ld(&bar[XB_XCNT(j)]); sum += c; cnt += (c > 0u) ? 1u : 0u; mine = (j == x) ? c : mine; }
        if (sum == G) break;
        __builtin_amdgcn_s_sleep(1);
        if ((++sp & 255u) == 0u) { if (xb_ld(&bar[XB_TMO])) break; if (sp > XB_SPIN_CAP) { atomicAdd(&bar[XB_TMO], 1u); break; } }
    }
    nloc = mine > 0u ? mine : 1u; nx = cnt > 0u ? cnt : 1u;
}
__device__ __forceinline__ void xcd_barrier(const XcdBarrier& b) {
    asm volatile("s_waitcnt vmcnt(0)" ::: "memory");
    __syncthreads();
    if (threadIdx.x == 0) {
        unsigned* bar = b.bar;
        __builtin_amdgcn_s_waitcnt(0);
        unsigned nloc = b.st[0], nx = b.st[1];
        if (nloc == 0u) { xcd_barrier_complete(bar, b.x, nloc, nx); b.st[0] = nloc; b.st[1] = nx; }
        const unsigned old = xb_add(&bar[XB_XSUB(b.x)], 1u);
        const unsigned gen = old / nloc;
        if (old + 1u == (gen + 1u) * nloc) {
            __builtin_amdgcn_fence(__ATOMIC_RELEASE, "agent");
            asm volatile("s_waitcnt vmcnt(0)" ::: "memory");
            const unsigned og = xb_add(&bar[XB_TOP], 1u);
            const unsigned tg = og / nx;
            if (og + 1u == (tg + 1u) * nx) xb_add(&bar[XB_TOPGEN], 1u);
            else XB_SPIN(xb_ld(&bar[XB_TOPGEN]) == tg, bar);
            __builtin_amdgcn_fence(__ATOMIC_ACQUIRE, "agent");
            xb_add(&bar[XB_XGEN(b.x)], 1u);
            asm volatile("s_waitcnt vmcnt(0)" ::: "memory");
        } else {
            XB_SPIN(xb_ld(&bar[XB_XGEN(b.x)]) == gen, bar);
            __builtin_amdgcn_fence(__ATOMIC_ACQUIRE, "agent");
            asm volatile("s_waitcnt vmcnt(0)" ::: "memory");
        }
    }
    __syncthreads();
}

struct Args { const void* in[17]; float* out; unsigned char* ws; int ph_lo, ph_hi, li, pad; };
struct Frame {
    LAS unsigned char* lds;
    volatile LAS unsigned* MISC;
    int wave, vcu, G;
    const void* const* in; float* out; unsigned char* ws;
};
#define IN_X(F)      ((const float*)(F).in[0])
#define IN_POS(F)    ((const int*)(F).in[1])
#define IN_NORMG(F)  ((const float*)(F).in[2])
#define IN_WIN(F)    ((const float*)(F).in[3])
#define IN_LQ1(F)    ((const float*)(F).in[4])
#define IN_LK1(F)    ((const float*)(F).in[5])
#define IN_LQ2(F)    ((const float*)(F).in[6])
#define IN_LK2(F)    ((const float*)(F).in[7])
#define IN_SUBLNG(F) ((const float*)(F).in[8])
#define IN_WOA(F)    ((const float*)(F).in[9])
#define IN_QNG(F)    ((const float*)(F).in[10])
#define IN_WUQ(F)    ((const float*)(F).in[11])
#define IN_KVNG(F)   ((const float*)(F).in[12])
#define IN_WUKV(F)   ((const float*)(F).in[13])
#define IN_WOB(F)    ((const float*)(F).in[14])
#define IN_WOUT(F)   ((const float*)(F).in[15])
#define IN_FINALG(F) ((const float*)(F).in[16])
#define W_CTL(F)    ((unsigned*)((F).ws + WS_CTL))
#define W_RSTDX(F)  ((float*)((F).ws + WS_RSTDX))
#define W_SSQQ(F)   ((float*)((F).ws + WS_SSQQ))
#define W_SSQKV(F)  ((float*)((F).ws + WS_SSQKV))
#define W_ROWSS(F)  ((float*)((F).ws + WS_ROWSS))
#define W_CS(F)     ((f32x2*)((F).ws + WS_CS))
#define W_WIN(F)    ((bf16*)((F).ws + WS_WIN))
#define W_WUQ(F)    ((bf16*)((F).ws + WS_WUQ))
#define W_WUKV(F)   ((bf16*)((F).ws + WS_WUKV))
#define W_WOAB(F)   ((bf16*)((F).ws + WS_WOAB))
#define W_WOUT(F)   ((bf16*)((F).ws + WS_WOUT))
#define W_KR(F)     ((bf16*)((F).ws + WS_KR))
#define W_XB(F)     ((bf16*)((F).ws + WS_XB))
#define W_KV(F)     ((bf16*)((F).ws + WS_KV))
#define W_Q(F)      ((bf16*)((F).ws + WS_Q))
#define W_AQ(F)     ((bf16*)((F).ws + WS_AQ))
#define W_AK(F)     ((bf16*)((F).ws + WS_AK))
#define W_AV(F)     ((bf16*)((F).ws + WS_AV))
#define W_MERGED(F) ((bf16*)((F).ws + WS_MERGED))
#define W_CQ(F)     ((bf16*)((F).ws + WS_CQ))
#define W_CKV(F)    ((bf16*)((F).ws + WS_CKV))
#define W_R(F)      ((bf16*)((F).ws + WS_R))
#define W_SB(F)     ((bf16*)((F).ws + WS_SB))
#define W_STASH(F)  ((float*)((F).ws + WS_STASH))
#define W_KRP(F)    ((float*)((F).ws + WS_KRP))
#define W_ABIN(F)   ((bf16*)((unsigned char*)(F).out + DO_ABIN))
#define W_AGS(F)    ((bf16*)((unsigned char*)(F).out + DO_AGS))
#define W_BGS(F)    ((bf16*)((unsigned char*)(F).out + DO_BGS))

__device__ __forceinline__ int win_src_col(int n) {
    const int t = n >> 8, c = n & 255;
    if (t < 20) return n;
    if (t < 24) return OFF_BG + (n - 5120);
    if (t < 40) { const int j = t - 24; return c < 128 ? OFF_MG + 128 * j + c : OFF_MG + 2048 + 128 * j + (c - 128); }
    if (c < 32) return OFF_KR + c;
    if (c >= 128 && c < 160) return OFF_KR + 32 + (c - 128);
    return -1;
}
__device__ __forceinline__ int wuq_src_col(int n) {
    const int t = n >> 8, c = n & 255;
    if (t < 4) return (2 * t + (c >> 7)) * 192 + (c & 127);
    const int u = t - 4, cc = c & 127, hh = 4 * u + (cc >> 5);
    return hh * 192 + 128 + (c >> 7) * 32 + (cc & 31);
}
__device__ __forceinline__ void p0_transpose_item(const float* W, int ldw, int src0, const float* gain, int k0, bf16* WT, int nrow0, int ldt, int kdst0, LAS float* scr, int lane) {
    const int kq = lane >> 3, n4 = (lane & 7) * 4;
    if (src0 >= 0) {
        f32x4 v[8];
#pragma unroll
        for (int i = 0; i < 8; ++i) v[i] = *(const f32x4*)(W + (size_t)(k0 + kq + 8 * i) * ldw + src0 + n4);
#pragma unroll
        for (int i = 0; i < 8; ++i) { const int kk = kq + 8 * i; const float g = gain ? gain[k0 + kk] : 1.f; LAS float* d = scr + kk * 33 + n4; d[0] = v[i].x * g; d[1] = v[i].y * g; d[2] = v[i].z * g; d[3] = v[i].w * g; }
    } else {
#pragma unroll
        for (int i = 0; i < 8; ++i) { LAS float* d = scr + (kq + 8 * i) * 33 + n4; d[0] = 0.f; d[1] = 0.f; d[2] = 0.f; d[3] = 0.f; }
    }
    LDS_WAIT(); asm volatile("" ::: "memory");
    const int c = lane & 7;
#pragma unroll
    for (int j = 0; j < 4; ++j) { const int n = (lane >> 3) + 8 * j; const LAS float* s = scr + (8 * c) * 33 + n;
        u32x4 o; o.x = pk2(s[0 * 33], s[1 * 33]); o.y = pk2(s[2 * 33], s[3 * 33]); o.z = pk2(s[4 * 33], s[5 * 33]); o.w = pk2(s[6 * 33], s[7 * 33]);
        *(u32x4*)(WT + (size_t)(nrow0 + n) * ldt + kdst0 + k0 + 8 * c) = o; }
    LDS_WAIT(); asm volatile("" ::: "memory");
}
__device__ __forceinline__ void p0_prologue(Frame& F) {
    LAS float* scr = (LAS float*)(F.lds + F.wave * 16384);
    const int gw = F.vcu * NWAVES + F.wave, NGW = F.G * NWAVES, lane = lane_id();
    constexpr int I_IN = (DM / 64) * (NP1 / 32), I_UQ = (512 / 64) * (NQ / 32), I_UKV = (512 / 64) * (NKV / 32), I_OA = (1024 / 64) * (DM / 32), I_OUT = (DM / 64) * (DM / 32);
    constexpr int NITEMS = I_IN + I_UQ + I_UKV + 2 * I_OA + I_OUT;
    for (int it = gw; it < NITEMS; it += NGW) {
        int r = it;
        if (r < I_IN) { const int nb = r % (NP1 / 32), kb = r / (NP1 / 32); p0_transpose_item(IN_WIN(F), IN_COLS, win_src_col(nb * 32), IN_NORMG(F), kb * 64, W_WIN(F), nb * 32, DM, 0, scr, lane); continue; } r -= I_IN;
        if (r < I_UQ) { const int nb = r % (NQ / 32), kb = r / (NQ / 32); p0_transpose_item(IN_WUQ(F), NQ, wuq_src_col(nb * 32), IN_QNG(F), kb * 64, W_WUQ(F), nb * 32, 512, 0, scr, lane); continue; } r -= I_UQ;
        if (r < I_UKV) { const int nb = r % (NKV / 32), kb = r / (NKV / 32); p0_transpose_item(IN_WUKV(F), NKV, nb * 32, IN_KVNG(F), kb * 64, W_WUKV(F), nb * 32, 512, 0, scr, lane); continue; } r -= I_UKV;
        if (r < I_OA) { const int nb = r % (DM / 32), kb = r / (DM / 32); p0_transpose_item(IN_WOA(F), DM, nb * 32, nullptr, kb * 64, W_WOAB(F), nb * 32, 2048, 0, scr, lane); continue; } r -= I_OA;
        if (r < I_OA) { const int nb = r % (DM / 32), kb = r / (DM / 32); p0_transpose_item(IN_WOB(F), DM, nb * 32, nullptr, kb * 64, W_WOAB(F), nb * 32, 2048, 1024, scr, lane); continue; } r -= I_OA;
        { const int nb = r % (DM / 32), kb = r / (DM / 32); p0_transpose_item(IN_WOUT(F), DM, nb * 32, nullptr, kb * 64, W_WOUT(F), nb * 32, 2048, 0, scr, lane); }
    }
    for (int m = gw; m < T; m += NGW) {
        const f32x4* xr = (const f32x4*)(IN_X(F) + (size_t)m * DM) + lane;
        f32x4 v[8]; float s = 0.f;
#pragma unroll
        for (int j = 0; j < 8; ++j) { v[j] = xr[64 * j]; s += (v[j].x * v[j].x + v[j].y * v[j].y) + (v[j].z * v[j].z + v[j].w * v[j].w); }
        s = wave_sum(s);
        if (lane == 0) W_RSTDX(F)[m] = 1.0f / sqrtf(s * (1.f / DM) + NORM_EPS);
        u32x2* o8 = (u32x2*)(W_XB(F) + (size_t)m * DM) + lane;
#pragma unroll
        for (int j = 0; j < 8; ++j) { u32x2 w; w.x = pk2(v[j].x, v[j].y); w.y = pk2(v[j].z, v[j].w); o8[64 * j] = w; }
    }
    for (int e = (F.vcu * NWAVES * 64 + F.wave * 64 + lane); e < T * 32; e += F.G * NWAVES * 64) {
        const int row = e >> 5, i = e & 31;
        const float inv = exp2f(-(float)i * (13.287712379549449f / 32.f));
        const float ang = (float)IN_POS(F)[row] * inv;
        const double a = (double)ang, n = __builtin_rint(a * 0.15915494309189535), rr = __builtin_fma(-n, 6.283185307179586, a);
        const float rf = (float)rr;
        W_CS(F)[e] = (f32x2){cosf(rf), sinf(rf)};
    }
}

template <class Epi> __device__ __forceinline__ void naive_gemm(const bf16* A, int lda, const bf16* Bt, int ldb, int M, int N, int K, const Epi& epi, int gw, int NGW, int lane, int kmid) {
    const int nN = N / 256, nU = (M / 16) * nN, fr = lane & 15, fq = lane >> 4;
    for (int u = gw; u < nU; u += NGW) {
        const int pn = u % nN, row0 = (u / nN) * 16;
        f32x4 acc[16];
#pragma unroll
        for (int t = 0; t < 16; ++t) acc[t] = (f32x4){0.f, 0.f, 0.f, 0.f};
        const bf16* ap = A + (size_t)(row0 + fr) * lda + 8 * fq; const bf16* bp = Bt + (size_t)(256 * pn + fr) * ldb + 8 * fq;
        for (int k0 = 0; k0 < K; k0 += 32) {
            if (kmid > 0 && k0 == kmid) epi.mid(acc, pn, row0, fr, fq);
            const bf16x8 a = *(const bf16x8*)(ap + k0);
#pragma unroll
            for (int t = 0; t < 16; ++t) { const bf16x8 b = *(const bf16x8*)(bp + (size_t)(16 * t) * ldb + k0); acc[t] = __builtin_amdgcn_mfma_f32_16x16x32_bf16(a, b, acc[t], 0, 0, 0); }
        }
        epi(acc, pn, row0, fr, fq);
    }
}
__device__ __forceinline__ float quad16_sum(float v) { v += __shfl_xor(v, 1); v += __shfl_xor(v, 2); v += __shfl_xor(v, 4); v += __shfl_xor(v, 8); return v; }
struct NEpiP1 {
    Frame F;
    __device__ __forceinline__ void mid(f32x4 (&)[16], int, int, int, int) const {}
    __device__ __forceinline__ void operator()(f32x4 (&acc)[16], int pn, int row0, int fr, int fq) const {
        const Frame& f = F;
#pragma unroll
        for (int i = 0; i < 4; ++i) {
            const int row = row0 + 4 * fq + i; const float rs = W_RSTDX(f)[row];
            if (pn < 16) {
                bf16* dst = pn < 4 ? W_AQ(f) : pn < 8 ? W_AK(f) : pn < 12 ? W_AV(f) : W_AGS(f); const int cb = (pn & 3) * 256 + fr;
#pragma unroll
                for (int t = 0; t < 16; ++t) { float v = acc[t][i] * rs; if (pn >= 12) v = silu_f(v); dst[(size_t)row * 1024 + cb + 16 * t] = (bf16)f2bf(v); }
            } else if (pn < 20) {
                bf16* dst = pn < 18 ? W_CQ(f) : W_CKV(f); float* ssq = pn < 18 ? W_SSQQ(f) : W_SSQKV(f); const int cb = (pn & 1) * 256 + fr; float s = 0.f;
#pragma unroll
                for (int t = 0; t < 16; ++t) { const float v = acc[t][i] * rs; s += v * v; dst[(size_t)row * 512 + cb + 16 * t] = (bf16)f2bf(v); }
                s = quad16_sum(s);
                if (fr < 4) ssq[(size_t)row * 8 + (pn & 1) * 4 + fr] = fr == 0 ? s : 0.f;
            } else if (pn < 24) {
                const int cb = (pn - 20) * 256 + fr;
#pragma unroll
                for (int t = 0; t < 16; ++t) W_BGS(f)[(size_t)row * 1024 + cb + 16 * t] = (bf16)f2bf(silu_f(acc[t][i] * rs));
            } else if (pn < 40) {
                const int cb = (pn - 24) * 128 + fr;
#pragma unroll
                for (int t = 0; t < 8; ++t) { const float sa = sigm_f(acc[t][i] * rs), sb = sigm_f(acc[t + 8][i] * rs);
                    W_R(f)[(size_t)row * 2048 + cb + 16 * t] = (bf16)f2bf(sa / sb); W_SB(f)[(size_t)row * 2048 + cb + 16 * t] = (bf16)f2bf(sb); }
            } else {
#pragma unroll
                for (int t = 0; t < 2; ++t) { const int c = 16 * t + fr; const float x1 = acc[t][i] * rs, x2 = acc[t + 8][i] * rs; const f32x2 cs = W_CS(f)[(size_t)row * 32 + c];
                    W_KR(f)[(size_t)row * 64 + c] = (bf16)f2bf(x1 * cs.x - x2 * cs.y); W_KR(f)[(size_t)row * 64 + 32 + c] = (bf16)f2bf(x1 * cs.y + x2 * cs.x); }
            }
        }
    }
};
__device__ __forceinline__ float rstd8(const float* p, float inv_n, float eps) { const f32x4 a = *(const f32x4*)p, b = *(const f32x4*)(p + 4); const float s = ((a.x + a.y) + (a.z + a.w)) + ((b.x + b.y) + (b.z + b.w)); return 1.0f / sqrtf(s * inv_n + eps); }
struct NEpiQ {
    Frame F;
    __device__ __forceinline__ void mid(f32x4 (&)[16], int, int, int, int) const {}
    __device__ __forceinline__ void operator()(f32x4 (&acc)[16], int pn, int row0, int fr, int fq) const {
        const Frame& f = F;
#pragma unroll
        for (int i = 0; i < 4; ++i) {
            const int row = row0 + 4 * fq + i; const float rs = rstd8(W_SSQQ(f) + (size_t)row * 8, 1.f / 512.f, NORM_EPS);
            if (pn < 4) {
#pragma unroll
                for (int t = 0; t < 16; ++t) { const int c = 16 * t + fr, head = 2 * pn + (c >> 7); W_Q(f)[(size_t)row * NQ + head * 192 + (c & 127)] = (bf16)f2bf(acc[t][i] * rs); }
            } else {
#pragma unroll
                for (int t = 0; t < 8; ++t) { const int c = 16 * t + fr, head = 4 * (pn - 4) + (c >> 5), ii = c & 31; const float x1 = acc[t][i] * rs, x2 = acc[t + 8][i] * rs; const f32x2 cs = W_CS(f)[(size_t)row * 32 + ii];
                    W_Q(f)[(size_t)row * NQ + head * 192 + 128 + ii] = (bf16)f2bf(x1 * cs.x - x2 * cs.y); W_Q(f)[(size_t)row * NQ + head * 192 + 160 + ii] = (bf16)f2bf(x1 * cs.y + x2 * cs.x); }
            }
        }
    }
};
struct NEpiKV {
    Frame F;
    __device__ __forceinline__ void mid(f32x4 (&)[16], int, int, int, int) const {}
    __device__ __forceinline__ void operator()(f32x4 (&acc)[16], int pn, int row0, int fr, int fq) const {
        const Frame& f = F;
#pragma unroll
        for (int i = 0; i < 4; ++i) {
            const int row = row0 + 4 * fq + i; const float rs = rstd8(W_SSQKV(f) + (size_t)row * 8, 1.f / 512.f, NORM_EPS);
#pragma unroll
            for (int t = 0; t < 16; ++t) W_KV(f)[(size_t)row * NKV + pn * 256 + 16 * t + fr] = (bf16)f2bf(acc[t][i] * rs);
        }
    }
};
struct NEpiMerge {
    Frame F;
    __device__ __forceinline__ void mid(f32x4 (&acc)[16], int pn, int row0, int fr, int fq) const {
        const Frame& f = F;
#pragma unroll
        for (int i = 0; i < 4; ++i) { const int row = row0 + 4 * fq + i;
#pragma unroll
            for (int t = 0; t < 16; ++t) acc[t][i] *= bf2f(W_R(f)[(size_t)row * 2048 + pn * 256 + 16 * t + fr]); }
    }
    __device__ __forceinline__ void operator()(f32x4 (&acc)[16], int pn, int row0, int fr, int fq) const {
        const Frame& f = F;
#pragma unroll
        for (int i = 0; i < 4; ++i) { const int row = row0 + 4 * fq + i;
#pragma unroll
            for (int t = 0; t < 16; ++t) { const size_t o = (size_t)row * 2048 + pn * 256 + 16 * t + fr; W_MERGED(f)[o] = (bf16)f2bf(acc[t][i] * bf2f(W_SB(f)[o])); } }
    }
};
struct NEpiOut {
    Frame F;
    __device__ __forceinline__ void mid(f32x4 (&)[16], int, int, int, int) const {}
    __device__ __forceinline__ void operator()(f32x4 (&acc)[16], int pn, int row0, int fr, int fq) const {
        const Frame& f = F;
#pragma unroll
        for (int i = 0; i < 4; ++i) { const int row = row0 + 4 * fq + i; float s = 0.f;
#pragma unroll
            for (int t = 0; t < 16; ++t) { const size_t o = (size_t)row * DM + pn * 256 + 16 * t + fr; const float y = IN_X(f)[o] + acc[t][i]; f.out[o] = y; s += y * y; }
            s = quad16_sum(s);
            if (fr < 4) W_ROWSS(f)[(size_t)row * 32 + pn * 4 + fr] = fr == 0 ? s : 0.f; }
    }
};

template <int DK1, int DK2> __device__ __forceinline__ f32x2 naive_attn_row(Frame& F, const bf16* qrow, const bf16* K1, int ldk1, const bf16* K2, int ldk2, const bf16* V, int ldv,
                                                                          float scale, float slope, float qpos, const int* kpos, LAS float* P, LAS float* qs) {
    const int lane = lane_id();
    for (int d = lane; d < DK1 + DK2; d += 64) qs[d] = bf2f(qrow[d]);
    LDS_WAIT(); asm volatile("" ::: "memory");
    float mx = -1e30f;
    for (int it = 0; it < SEQ / 64; ++it) {
        const int j = it * 64 + lane; float s = 0.f;
        const bf16* kp = K1 + (size_t)j * ldk1;
#pragma unroll
        for (int c = 0; c < DK1 / 8; ++c) { const u32x4 w = *(const u32x4*)(kp + 8 * c);
            s += qs[8 * c + 0] * bflo(w.x) + qs[8 * c + 1] * bfhi(w.x) + qs[8 * c + 2] * bflo(w.y) + qs[8 * c + 3] * bfhi(w.y) + qs[8 * c + 4] * bflo(w.z) + qs[8 * c + 5] * bfhi(w.z) + qs[8 * c + 6] * bflo(w.w) + qs[8 * c + 7] * bfhi(w.w); }
        if (DK2 > 0) { const bf16* kp2 = K2 + (size_t)j * ldk2;
#pragma unroll
            for (int c = 0; c < DK2 / 8; ++c) { const u32x4 w = *(const u32x4*)(kp2 + 8 * c); const LAS float* q2 = qs + DK1 + 8 * c;
                s += q2[0] * bflo(w.x) + q2[1] * bfhi(w.x) + q2[2] * bflo(w.y) + q2[3] * bfhi(w.y) + q2[4] * bflo(w.z) + q2[5] * bfhi(w.z) + q2[6] * bflo(w.w) + q2[7] * bfhi(w.w); } }
        s = s * scale - slope * fabsf(qpos - (float)kpos[j]);
        P[j] = s; mx = fmaxf(mx, s);
    }
    mx = wave_max(mx);
    LDS_WAIT(); asm volatile("" ::: "memory");
    float l = 0.f;
    for (int it = 0; it < SEQ / 64; ++it) { const int j = it * 64 + lane; const float p = __expf(P[j] - mx); P[j] = p; l += p; }
    l = wave_sum(l);
    LDS_WAIT(); asm volatile("" ::: "memory");
    float o0 = 0.f, o1 = 0.f; const bf16* vp = V + 2 * lane;
#pragma unroll 8
    for (int j = 0; j < SEQ; ++j) { const float p = P[j]; const unsigned w = *(const unsigned*)(vp + (size_t)j * ldv); o0 += p * bflo(w); o1 += p * bfhi(w); }
    LDS_WAIT(); asm volatile("" ::: "memory");
    const float il = 1.f / l;
    return (f32x2){o0 * il, o1 * il};
}
__device__ __forceinline__ float lambda_full(Frame& F) {
    const int lane = lane_id();
    const float a = wave_sum(IN_LQ1(F)[lane] * IN_LK1(F)[lane]), b = wave_sum(IN_LQ2(F)[lane] * IN_LK2(F)[lane]);
    return __expf(a) - __expf(b) + LAM_INIT;
}
__device__ __forceinline__ void p3_naive(Frame& F) {
    LAS float* P = (LAS float*)(F.lds) + F.wave * SEQ; LAS float* qs = (LAS float*)(F.lds + 131072) + F.wave * 192;
    const float lam = lambda_full(F); const int lane = lane_id();
    for (int u = F.vcu; u < NB * 8 * (SEQ / 8); u += F.G) {
        const int r8 = u % (SEQ / 8), bh = u / (SEQ / 8), h = bh % 8, b = bh / 8, row = b * SEQ + r8 * 8 + F.wave;
        const float slope = exp2f(-(float)(h + 1)), qpos = (float)IN_POS(F)[row]; const int* kpos = IN_POS(F) + b * SEQ;
        const bf16* kb = W_AK(F) + (size_t)b * SEQ * 1024 + h * 128; const bf16* vb = W_AV(F) + (size_t)b * SEQ * 1024 + h * 128; const bf16* qb = W_AQ(F) + (size_t)row * 1024 + h * 128;
        const f32x2 o1 = naive_attn_row<64, 0>(F, qb, kb, 1024, nullptr, 0, vb, 1024, 0.125f, slope, qpos, kpos, P, qs);
        const f32x2 o2 = naive_attn_row<64, 0>(F, qb + 64, kb + 64, 1024, nullptr, 0, vb, 1024, 0.125f, slope, qpos, kpos, P, qs);
        const float d0 = o1.x - lam * o2.x, d1 = o1.y - lam * o2.y;
        const float ss = wave_sum(d0 * d0 + d1 * d1), rs = 1.0f / sqrtf(ss * (1.f / 128.f) + SUBLN_EPS);
        const unsigned gw_ = *(const unsigned*)(W_AGS(F) + (size_t)row * 1024 + h * 128 + 2 * lane);
        const float y0 = d0 * rs * IN_SUBLNG(F)[2 * lane] * (1.f - LAM_INIT) * bflo(gw_), y1 = d1 * rs * IN_SUBLNG(F)[2 * lane + 1] * (1.f - LAM_INIT) * bfhi(gw_);
        *(unsigned*)(W_ABIN(F) + (size_t)row * 2048 + h * 128 + 2 * lane) = pk2(y0, y1);
    }
    for (int u = F.vcu; u < NB * 8 * (SEQ / 8); u += F.G) {
        const int r8 = u % (SEQ / 8), bh = u / (SEQ / 8), h = bh % 8, b = bh / 8, row = b * SEQ + r8 * 8 + F.wave;
        const bf16* kb = W_KV(F) + (size_t)b * SEQ * NKV + h * 256; const bf16* krb = W_KR(F) + (size_t)b * SEQ * 64; const bf16* qb = W_Q(F) + (size_t)row * NQ + h * 192;
        const f32x2 o = naive_attn_row<128, 64>(F, qb, kb, NKV, krb, 64, kb + 128, NKV, 0.07216878364870322f, 0.f, 0.f, IN_POS(F) + b * SEQ, P, qs);
        const unsigned gw_ = *(const unsigned*)(W_BGS(F) + (size_t)row * 1024 + h * 128 + 2 * lane);
        *(unsigned*)(W_ABIN(F) + (size_t)row * 2048 + 1024 + h * 128 + 2 * lane) = pk2(o.x * bflo(gw_), o.y * bfhi(gw_));
    }
}

namespace pg8 {
constexpr int BM = 256, BK = 64, HALF = 128, HTB = HALF * BK * 2, STAGE_BYTES = 8 * HTB, NXCD = 8, WGM = 8;
__host__ __device__ __forceinline__ int lds_byte(int r, int c) { const int st = (r >> 4) * 2 + (c >> 5), rr = r & 15, cc = c & 31, ob = rr * 64 + cc * 2; return st * 1024 + (ob ^ (((ob >> 9) & 1) << 5)); }
__host__ __device__ __forceinline__ void stage_rc(int b, int& R, int& C) { const int st = b / 1024, sb = b % 1024, swz = sb ^ (((sb >> 9) & 1) << 5); R = (st >> 1) * 16 + swz / 64; C = (st & 1) * 32 + (swz % 64) / 2; }
__host__ __device__ __forceinline__ int perm32(int rho) { const int n = rho >> 4, i = rho & 15; return 8 * (i >> 2) + 4 * n + (i & 3); }
struct Unit { int pm, pn, part; };
struct StaticOrder {
    int nM, nN, nwg, G, c;
    __device__ void init(int M, int N, int G_, int c_) { nM = M / BM; nN = N / BM; nwg = nM * nN; G = G_; c = c_; }
    __device__ bool next(int i, Unit& u) const {
        const long L = (long)i * G + c; if (L >= nwg) return false;
        int wgid = (int)L; { const int q = nwg / NXCD, r = nwg % NXCD, xcd = wgid % NXCD, off = wgid / NXCD; wgid = (xcd < r ? xcd * (q + 1) : r * (q + 1) + (xcd - r) * q) + off; }
        const int nig = WGM * nN, gid = wgid / nig, fm = gid * WGM, gsz = (nM - fm) < WGM ? (nM - fm) : WGM;
        u.pm = fm + ((wgid % nig) % gsz); u.pn = (wgid % nig) / gsz; u.part = 0; return true;
    }
};
__device__ __forceinline__ unsigned cvt_pk_bf16(float lo, float hi) { unsigned r; asm volatile("v_cvt_pk_bf16_f32 %0, %1, %2" : "=v"(r) : "v"(lo), "v"(hi)); return r; }
__device__ __forceinline__ u32x4 pack8(const f32x4 v0, const f32x4 v1) { u32x4 w; w.x = cvt_pk_bf16(v0[0], v0[1]); w.y = cvt_pk_bf16(v0[2], v0[3]); w.z = cvt_pk_bf16(v1[0], v1[1]); w.w = cvt_pk_bf16(v1[2], v1[3]); return w; }
__device__ __forceinline__ void unpack8(const u32x4 w, f32x4& v0, f32x4& v1) { v0 = (f32x4){bflo(w.x), bfhi(w.x), bflo(w.y), bfhi(w.y)}; v1 = (f32x4){bflo(w.z), bfhi(w.z), bflo(w.w), bfhi(w.w)}; }

template <class Epi, class Sched, class Src>
__device__ __forceinline__ void gemm_phase(LAS unsigned char* lds, const int K  , const int nt  , const Sched& S, const Src& P, const Epi& E) {
    const int wid = __builtin_amdgcn_readfirstlane((int)threadIdx.x >> 6), lane = lane_id(), tid = wid * 64 + lane, wr = wid >> 2, wc = wid & 3, fr = lane & 15, fq = lane >> 4;
    unsigned voffA[2], voffB[2];
#pragma unroll
    for (int i = 0; i < 2; ++i) { int R, C; stage_rc(tid * 16 + i * 8192, R, C); const int Rb = Epi::PERM ? ((R & ~31) + perm32(R & 31)) : R;
        voffA[i] = (unsigned)(R * K + C) * 2u; voffB[i] = (unsigned)(Rb * K + C) * 2u; }
    const size_t kstep = (size_t)(BK * 2);
    const size_t hstep = (size_t)HALF * K * 2;
    const unsigned ldsw = (unsigned)wid * 1024u;
    const int aoff = lds_byte(wr * 64 + fr, fq * 8), boff = lds_byte(wc * 32 + fr, fq * 8);
#define PG8_SA(b, h) (((b) * 2 + (h)) * HTB)
#define PG8_SB(b, h) ((4 + (b) * 2 + (h)) * HTB)
#define PG8_STAGE(bufoff, gbase, voff) do { _Pragma("unroll") for (int _i = 0; _i < 2; ++_i) \
        __builtin_amdgcn_global_load_lds((const unsigned*)((const char*)(gbase) + (voff)[_i]), (LAS unsigned*)(lds + (bufoff) + ldsw + _i * 8192), 16, 0, 0); } while (0)
#define PG8_LDA(dst, b, h) do { _Pragma("unroll") for (int m = 0; m < 4; ++m) _Pragma("unroll") for (int k = 0; k < 2; ++k) dst[m][k] = *(const LAS bf16x8*)(lds + PG8_SA(b, h) + aoff + m * 2048 + k * 1024); } while (0)
#define PG8_LDB(dst, b, h) do { _Pragma("unroll") for (int n = 0; n < 2; ++n) _Pragma("unroll") for (int k = 0; k < 2; ++k) dst[n][k] = *(const LAS bf16x8*)(lds + PG8_SB(b, h) + boff + n * 2048 + k * 1024); } while (0)
#define PG8_MMA(ai, bj, At, Bt) do { __builtin_amdgcn_s_setprio(1); _Pragma("unroll") for (int m = 0; m < 4; ++m) _Pragma("unroll") for (int n = 0; n < 2; ++n) _Pragma("unroll") for (int k = 0; k < 2; ++k) \
        acc[ai][bj][m][n] = __builtin_amdgcn_mfma_f32_16x16x32_bf16(Bt[n][k], At[m][k], acc[ai][bj][m][n], 0, 0, 0); __builtin_amdgcn_s_setprio(0); } while (0)
#define PG8_WAIT_V(n) asm volatile("s_waitcnt vmcnt(" #n ")" ::: "memory")
#define PG8_WAIT_L(n) asm volatile("s_waitcnt lgkmcnt(" #n ")" ::: "memory")
#define PG8_BAR __builtin_amdgcn_s_barrier()
#define PG8_SCHED __builtin_amdgcn_sched_barrier(0)
    Unit cur, nxt; int ui = 0;
    if (!S.next(0, cur)) return;
    f32x4 acc[2][2][4][2];
#pragma unroll
    for (int a = 0; a < 2; ++a)
#pragma unroll
        for (int b = 0; b < 2; ++b)
#pragma unroll
            for (int m = 0; m < 4; ++m)
#pragma unroll
                for (int n = 0; n < 2; ++n) acc[a][b][m][n] = (f32x4){0.f, 0.f, 0.f, 0.f};
    bf16x8 At[4][2], B0[2][2], B1[2][2];
    const char* cA = P.a(cur); const char* cB = P.b(cur);
    PG8_STAGE(PG8_SB(0, 0), cB, voffB); PG8_STAGE(PG8_SB(0, 1), cB + hstep, voffB); PG8_STAGE(PG8_SA(0, 0), cA, voffA); PG8_STAGE(PG8_SA(0, 1), cA + hstep, voffA);
    if (wr == 1) PG8_BAR;
    PG8_WAIT_V(2); PG8_BAR;
    PG8_STAGE(PG8_SB(1, 0), cB + kstep, voffB); PG8_STAGE(PG8_SA(1, 0), cA + kstep, voffA); PG8_STAGE(PG8_SB(1, 1), cB + hstep + kstep, voffB);
    PG8_WAIT_V(6); PG8_BAR;
    for (;;) {
        const bool has_next = S.next(ui + 1, nxt);
        const char* nA = has_next ? P.a(nxt) : cA; const char* nB = has_next ? P.b(nxt) : cB;
        for (int t = 0; t < nt; t += 2) {
            const bool last = (t == nt - 2);
            const char* a1 = cA + (size_t)(t + 1) * kstep;
            const char* a2 = last ? nA : cA + (size_t)(t + 2) * kstep; const char* b2 = last ? nB : cB + (size_t)(t + 2) * kstep;
            const char* a3 = a2 + kstep; const char* b3 = b2 + kstep;
            PG8_LDB(B0, 0, 0); PG8_LDB(B1, 0, 1); PG8_SCHED; PG8_LDA(At, 0, 0); PG8_STAGE(PG8_SA(1, 1), a1 + hstep, voffA);
            PG8_WAIT_V(8); PG8_WAIT_L(0); PG8_BAR; PG8_MMA(0, 0, At, B0); PG8_MMA(0, 1, At, B1); PG8_BAR; PG8_SCHED;
            PG8_LDA(At, 0, 1); PG8_STAGE(PG8_SB(0, 0), b2, voffB); PG8_STAGE(PG8_SB(0, 1), b2 + hstep, voffB); PG8_STAGE(PG8_SA(0, 0), a2, voffA);
            PG8_WAIT_V(8); PG8_WAIT_L(0); PG8_BAR; PG8_MMA(1, 0, At, B0); PG8_MMA(1, 1, At, B1); PG8_BAR; PG8_SCHED;
            PG8_LDB(B0, 1, 0); PG8_LDB(B1, 1, 1); PG8_SCHED; PG8_LDA(At, 1, 0); PG8_STAGE(PG8_SA(0, 1), a2 + hstep, voffA);
            PG8_WAIT_V(8); PG8_WAIT_L(0); PG8_BAR; PG8_MMA(0, 0, At, B0); PG8_MMA(0, 1, At, B1); PG8_BAR; PG8_SCHED;
            PG8_LDA(At, 1, 1); PG8_STAGE(PG8_SB(1, 0), b3, voffB); PG8_STAGE(PG8_SB(1, 1), b3 + hstep, voffB); PG8_STAGE(PG8_SA(1, 0), a3, voffA);
            PG8_WAIT_V(8); PG8_WAIT_L(0); PG8_BAR; PG8_MMA(1, 0, At, B0); PG8_MMA(1, 1, At, B1); PG8_BAR; PG8_SCHED;
        }
        if (wr == 0) PG8_BAR;
        E(acc, cur, wr, wc, fr, fq);
        if (!has_next) break;
        if (!Epi::keep(cur)) {
#pragma unroll
        for (int a = 0; a < 2; ++a)
#pragma unroll
            for (int b = 0; b < 2; ++b)
#pragma unroll
                for (int m = 0; m < 4; ++m)
#pragma unroll
                    for (int n = 0; n < 2; ++n) acc[a][b][m][n] = (f32x4){0.f, 0.f, 0.f, 0.f};
        }
        cur = nxt; cA = nA; cB = nB; ++ui;
        if (wr == 1) PG8_BAR;
    }
    PG8_WAIT_V(0);
    PG8_BAR;
#undef PG8_SA
#undef PG8_SB
#undef PG8_STAGE
#undef PG8_LDA
#undef PG8_LDB
#undef PG8_MMA
#undef PG8_WAIT_V
#undef PG8_WAIT_L
#undef PG8_BAR
#undef PG8_SCHED
}
}

struct SrcPlain { const char* A; const char* B; size_t tstep;
    __device__ __forceinline__ const char* a(const pg8::Unit& u) const { return A + (size_t)u.pm * tstep; }
    __device__ __forceinline__ const char* b(const pg8::Unit& u) const { return B + (size_t)u.pn * tstep; } };
struct SrcP2 { const char *A0, *A1, *B0, *B1; size_t tstep;
    __device__ __forceinline__ const char* a(const pg8::Unit& u) const { return (u.pn < 6 ? A0 : A1) + (size_t)u.pm * tstep; }
    __device__ __forceinline__ const char* b(const pg8::Unit& u) const { return u.pn < 6 ? B0 + (size_t)u.pn * tstep : B1 + (size_t)(u.pn - 6) * tstep; } };

__device__ __forceinline__ float fq_sum(float v) { v += __shfl_xor(v, 16); v += __shfl_xor(v, 32); return v; }
struct EpiP1 {
    static constexpr bool PERM = true; static __device__ __forceinline__ bool keep(const pg8::Unit&) { return false; }
    Frame F;
    __device__ __forceinline__ void operator()(f32x4 (&acc)[2][2][4][2], const pg8::Unit& u, int wr, int wc, int fr, int fq) const {
        const int pn = u.pn, row0 = u.pm * 256 + wr * 64 + fr, c8 = 32 * wc + 8 * fq;
        const float* rstd = W_RSTDX(F);
        if (pn < 16 || (pn >= 20 && pn < 24)) {
            bf16* dst; int cb; bool act = false;
            if (pn < 4) { dst = W_AQ(F); cb = pn * 256; } else if (pn < 8) { dst = W_AK(F); cb = (pn - 4) * 256; } else if (pn < 12) { dst = W_AV(F); cb = (pn - 8) * 256; }
            else if (pn < 16) { dst = W_AGS(F); cb = (pn - 12) * 256; act = true; } else { dst = W_BGS(F); cb = (pn - 20) * 256; act = true; }
#pragma unroll
            for (int ai = 0; ai < 2; ++ai)
#pragma unroll
                for (int m = 0; m < 4; ++m) { const int row = row0 + ai * 128 + m * 16; const float rs = rstd[row]; bf16* rowp = dst + (size_t)row * 1024 + cb + c8;
#pragma unroll
                    for (int bj = 0; bj < 2; ++bj) { f32x4 v0 = acc[ai][bj][m][0] * rs, v1 = acc[ai][bj][m][1] * rs;
                        if (act) {
#pragma unroll
                            for (int e = 0; e < 4; ++e) { v0[e] = silu_f(v0[e]); v1[e] = silu_f(v1[e]); } }
                        *(u32x4*)(rowp + bj * 128) = pg8::pack8(v0, v1); } }
        } else if (pn < 20) {
            bf16* dst = pn < 18 ? W_CQ(F) : W_CKV(F); float* ssq = pn < 18 ? W_SSQQ(F) : W_SSQKV(F); const int cb = (pn & 1) * 256;
#pragma unroll
            for (int ai = 0; ai < 2; ++ai)
#pragma unroll
                for (int m = 0; m < 4; ++m) { const int row = row0 + ai * 128 + m * 16; const float rs = rstd[row]; bf16* rowp = dst + (size_t)row * 512 + cb + c8; float s = 0.f;
#pragma unroll
                    for (int bj = 0; bj < 2; ++bj) { const f32x4 v0 = acc[ai][bj][m][0] * rs, v1 = acc[ai][bj][m][1] * rs;
                        s += (v0[0] * v0[0] + v0[1] * v0[1]) + (v0[2] * v0[2] + v0[3] * v0[3]) + (v1[0] * v1[0] + v1[1] * v1[1]) + (v1[2] * v1[2] + v1[3] * v1[3]);
                        *(u32x4*)(rowp + bj * 128) = pg8::pack8(v0, v1); }
                    s = fq_sum(s);
                    if (fq == 0) ssq[(size_t)row * 8 + (pn & 1) * 4 + wc] = s; }
        } else if (pn < 40) {
            bf16* Rp = W_R(F); bf16* Sp = W_SB(F); const int cb = (pn - 24) * 128 + c8;
#pragma unroll
            for (int ai = 0; ai < 2; ++ai)
#pragma unroll
                for (int m = 0; m < 4; ++m) { const int row = row0 + ai * 128 + m * 16; const float rs = rstd[row]; f32x4 r0, r1, s0, s1;
#pragma unroll
                    for (int e = 0; e < 4; ++e) { const float sa0 = sigm_f(acc[ai][0][m][0][e] * rs), sb0 = sigm_f(acc[ai][1][m][0][e] * rs), sa1 = sigm_f(acc[ai][0][m][1][e] * rs), sb1 = sigm_f(acc[ai][1][m][1][e] * rs);
                        r0[e] = sa0 / sb0; s0[e] = sb0; r1[e] = sa1 / sb1; s1[e] = sb1; }
                    *(u32x4*)(Rp + (size_t)row * 2048 + cb) = pg8::pack8(r0, r1); *(u32x4*)(Sp + (size_t)row * 2048 + cb) = pg8::pack8(s0, s1); }
        }
    }
};
struct EpiKR {
    static constexpr bool PERM = true; static __device__ __forceinline__ bool keep(const pg8::Unit&) { return false; }
    Frame F;
    __device__ __forceinline__ void operator()(f32x4 (&acc)[2][2][4][2], const pg8::Unit& u, int wr, int wc, int fr, int fq) const {
        if (wc != 0) return;
        float* krp = W_KRP(F) + ((size_t)u.part * T + u.pm * 256 + wr * 64 + fr) * 64 + 8 * fq;
#pragma unroll
        for (int ai = 0; ai < 2; ++ai)
#pragma unroll
            for (int m = 0; m < 4; ++m)
#pragma unroll
                for (int bj = 0; bj < 2; ++bj)
#pragma unroll
                    for (int n = 0; n < 2; ++n) *(f32x4*)(krp + (size_t)(ai * 128 + m * 16) * 64 + bj * 32 + 4 * n) = acc[ai][bj][m][n];
    }
};
struct OrderKR { int G, c;
    __device__ bool next(int i, pg8::Unit& u) const { const int L = i * G + c; if (L >= 256) return false; u.pm = L >> 2; u.pn = 40; u.part = L & 3; return true; } };
struct SrcKR { const char* A; const char* B; size_t tstep;
    __device__ __forceinline__ const char* a(const pg8::Unit& u) const { return A + (size_t)u.pm * tstep + (size_t)u.part * 1024; }
    __device__ __forceinline__ const char* b(const pg8::Unit& u) const { return B + (size_t)40 * tstep + (size_t)u.part * 1024; } };
__device__ __forceinline__ void kr_finish(Frame& F) {
    const float* krp = W_KRP(F); const float* rstd = W_RSTDX(F); const f32x2* cs = W_CS(F); bf16* kr = W_KR(F);
    for (int e = (F.vcu * NWAVES + F.wave) * 64 + lane_id(); e < T * 32; e += F.G * NWAVES * 64) {
        const int row = e >> 5, i = e & 31; float x1 = 0.f, x2 = 0.f;
#pragma unroll
        for (int sl = 0; sl < 4; ++sl) { x1 += krp[((size_t)sl * T + row) * 64 + i]; x2 += krp[((size_t)sl * T + row) * 64 + 32 + i]; }
        const float rs = rstd[row]; x1 *= rs; x2 *= rs; const f32x2 c = cs[e];
        kr[(size_t)row * 64 + i] = (bf16)f2bf(x1 * c.x - x2 * c.y); kr[(size_t)row * 64 + 32 + i] = (bf16)f2bf(x1 * c.y + x2 * c.x);
    }
}
struct EpiP2 {
    static constexpr bool PERM = true; static __device__ __forceinline__ bool keep(const pg8::Unit&) { return false; }
    Frame F;
    __device__ __forceinline__ void operator()(f32x4 (&acc)[2][2][4][2], const pg8::Unit& u, int wr, int wc, int fr, int fq) const {
        const int pn = u.pn, row0 = u.pm * 256 + wr * 64 + fr, c8 = 32 * wc + 8 * fq;
        if (pn < 4) {
            bf16* q = W_Q(F); const float* ssq = W_SSQQ(F);
#pragma unroll
            for (int ai = 0; ai < 2; ++ai)
#pragma unroll
                for (int m = 0; m < 4; ++m) { const int row = row0 + ai * 128 + m * 16; const float rs = rstd8(ssq + (size_t)row * 8, 1.f / 512.f, NORM_EPS);
#pragma unroll
                    for (int bj = 0; bj < 2; ++bj) *(u32x4*)(q + (size_t)row * NQ + (2 * pn + bj) * 192 + c8) = pg8::pack8(acc[ai][bj][m][0] * rs, acc[ai][bj][m][1] * rs); }
        } else if (pn < 6) {
            bf16* q = W_Q(F); const float* ssq = W_SSQQ(F); const f32x2* cs = W_CS(F); const int head = 4 * (pn - 4) + wc;
#pragma unroll
            for (int ai = 0; ai < 2; ++ai)
#pragma unroll
                for (int m = 0; m < 4; ++m) { const int row = row0 + ai * 128 + m * 16; const float rs = rstd8(ssq + (size_t)row * 8, 1.f / 512.f, NORM_EPS); const f32x4* cp = (const f32x4*)(cs + (size_t)row * 32 + 8 * fq); f32x4 a0, a1, b0, b1;
#pragma unroll
                    for (int n = 0; n < 2; ++n) { const f32x4 x1 = acc[ai][0][m][n] * rs, x2 = acc[ai][1][m][n] * rs; const f32x4 c01 = cp[2 * n], c23 = cp[2 * n + 1];
                        f32x4 o1, o2;
                        o1[0] = x1[0] * c01[0] - x2[0] * c01[1]; o2[0] = x1[0] * c01[1] + x2[0] * c01[0]; o1[1] = x1[1] * c01[2] - x2[1] * c01[3]; o2[1] = x1[1] * c01[3] + x2[1] * c01[2];
                        o1[2] = x1[2] * c23[0] - x2[2] * c23[1]; o2[2] = x1[2] * c23[1] + x2[2] * c23[0]; o1[3] = x1[3] * c23[2] - x2[3] * c23[3]; o2[3] = x1[3] * c23[3] + x2[3] * c23[2];
                        if (n == 0) { a0 = o1; b0 = o2; } else { a1 = o1; b1 = o2; } }
                    *(u32x4*)(q + (size_t)row * NQ + head * 192 + 128 + 8 * fq) = pg8::pack8(a0, a1); *(u32x4*)(q + (size_t)row * NQ + head * 192 + 160 + 8 * fq) = pg8::pack8(b0, b1); }
        } else {
            bf16* kv = W_KV(F); const float* ssq = W_SSQKV(F);
#pragma unroll
            for (int ai = 0; ai < 2; ++ai)
#pragma unroll
                for (int m = 0; m < 4; ++m) { const int row = row0 + ai * 128 + m * 16; const float rs = rstd8(ssq + (size_t)row * 8, 1.f / 512.f, NORM_EPS);
#pragma unroll
                    for (int bj = 0; bj < 2; ++bj) *(u32x4*)(kv + (size_t)row * NKV + (pn - 6) * 256 + bj * 128 + c8) = pg8::pack8(acc[ai][bj][m][0] * rs, acc[ai][bj][m][1] * rs); }
        }
    }
};
struct EpiP4 {
    static constexpr bool PERM = true; static __device__ __forceinline__ bool keep(const pg8::Unit& u) { return u.part == 0; }
    Frame F;
    __device__ __forceinline__ void operator()(f32x4 (&acc)[2][2][4][2], const pg8::Unit& u, int wr, int wc, int fr, int fq) const {
        const size_t o0 = (size_t)(u.pm * 256 + wr * 64 + fr) * 2048 + u.pn * 256 + 32 * wc + 8 * fq;
        if (u.part == 0) {
            const bf16* Rp = W_R(F);
#pragma unroll
            for (int ai = 0; ai < 2; ++ai)
#pragma unroll
                for (int m = 0; m < 4; ++m) {
#pragma unroll
                    for (int bj = 0; bj < 2; ++bj) { const u32x4 w = *(const u32x4*)(Rp + o0 + (size_t)(ai * 128 + m * 16) * 2048 + bj * 128); f32x4 r0, r1; pg8::unpack8(w, r0, r1); acc[ai][bj][m][0] *= r0; acc[ai][bj][m][1] *= r1; }
                    if (m & 1) asm volatile("" ::: "memory"); }
        } else {
            const bf16* Sp = W_SB(F); bf16* Mp = W_MERGED(F);
#pragma unroll
            for (int ai = 0; ai < 2; ++ai)
#pragma unroll
                for (int m = 0; m < 4; ++m) {
#pragma unroll
                    for (int bj = 0; bj < 2; ++bj) { const size_t o = o0 + (size_t)(ai * 128 + m * 16) * 2048 + bj * 128; const u32x4 w = *(const u32x4*)(Sp + o); f32x4 s0, s1; pg8::unpack8(w, s0, s1);
                        *(u32x4*)(Mp + o) = pg8::pack8(acc[ai][bj][m][0] * s0, acc[ai][bj][m][1] * s1); }
                    if (m & 1) asm volatile("" ::: "memory"); }
        }
    }
};
struct OrderP4 { pg8::StaticOrder S;
    __device__ bool next(int i, pg8::Unit& u) const { if (!S.next(i >> 1, u)) return false; u.part = i & 1; return true; } };
struct SrcP4 { const char* A; const char* B; size_t tstep;
    __device__ __forceinline__ const char* a(const pg8::Unit& u) const { return A + (size_t)u.pm * tstep + (size_t)u.part * 2048; }
    __device__ __forceinline__ const char* b(const pg8::Unit& u) const { return B + (size_t)u.pn * tstep + (size_t)u.part * 2048; } };
struct EpiP5 {
    static constexpr bool PERM = false; static __device__ __forceinline__ bool keep(const pg8::Unit&) { return false; }
    Frame F;
    __device__ __forceinline__ void operator()(f32x4 (&acc)[2][2][4][2], const pg8::Unit& u, int wr, int wc, int fr, int fq) const {
        const int row0 = u.pm * 256 + wr * 64 + fr, col0 = u.pn * 256 + wc * 32 + 4 * fq; const float* x = IN_X(F); float* out = F.out; float* rowss = W_ROWSS(F);
#pragma unroll
        for (int ai = 0; ai < 2; ++ai)
#pragma unroll
            for (int m = 0; m < 4; ++m) { const int row = row0 + ai * 128 + m * 16; const size_t o = (size_t)row * DM + col0; float s = 0.f;
#pragma unroll
                for (int bj = 0; bj < 2; ++bj)
#pragma unroll
                    for (int n = 0; n < 2; ++n) { const f32x4 y = *(const f32x4*)(x + o + bj * 128 + n * 16) + acc[ai][bj][m][n]; *(f32x4*)(out + o + bj * 128 + n * 16) = y; s += (y[0] * y[0] + y[1] * y[1]) + (y[2] * y[2] + y[3] * y[3]); }
                s = fq_sum(s);
                if (fq == 0) rowss[(size_t)row * 32 + u.pn * 4 + wc] = s; }
    }
};

namespace att {
typedef float f32x16 __attribute__((ext_vector_type(16)));
typedef short s16x4 __attribute__((ext_vector_type(4)));
constexpr int SHM_V = 16384, KBUF = 24576, OFF_K = 2 * SHM_V, OFF_KR = 16384, OFF_WS = OFF_K + 2 * KBUF, OFF_KPOS = OFF_WS + 2048, ATT_LDS = OFF_KPOS + 65536;
constexpr float THR = 8.f;
#define SBAR() __builtin_amdgcn_sched_barrier(0)
__device__ __forceinline__ int crow(int r, int hi) { return (r & 3) + 8 * (r >> 2) + 4 * hi; }
__device__ __forceinline__ unsigned cvtpk(float lo, float hi) { unsigned r; asm volatile("v_cvt_pk_bf16_f32 %0, %1, %2" : "=v"(r) : "v"(lo), "v"(hi)); return r; }
template <int MODE> __device__ __forceinline__ void partialSM(f32x16& p0, f32x16& p1, float& m_reg, float& mn, float& alpha, float qpos, float nslope, const LAS float* kp) {
  constexpr float SCALE = MODE == 0 ? 0.125f : 0.07216878364870322f, C = SCALE * 1.4426950408889634f;
  if (MODE == 0) {
#pragma unroll
    for (int g = 0; g < 4; ++g) { const f32x4 ka = *(const LAS f32x4*)(kp + 8 * g), kb = *(const LAS f32x4*)(kp + 32 + 8 * g);
#pragma unroll
      for (int e = 0; e < 4; ++e) { p0[4 * g + e] = fmaf(nslope, fabsf(qpos - ka[e]), p0[4 * g + e]); p1[4 * g + e] = fmaf(nslope, fabsf(qpos - kb[e]), p1[4 * g + e]); } }
  }
  float pmax = p0[0];
#pragma unroll
  for (int r = 1; r < 16; ++r) pmax = fmaxf(pmax, p0[r]);
#pragma unroll
  for (int r = 0; r < 16; ++r) pmax = fmaxf(pmax, p1[r]);
  { auto rr = __builtin_amdgcn_permlane32_swap(__float_as_uint(pmax), __float_as_uint(pmax), false, false);
    pmax = fmaxf(__uint_as_float(rr[0]), __uint_as_float(rr[1])); }
  if (__builtin_expect(__all(pmax - m_reg <= THR / SCALE), 1)) { mn = m_reg; alpha = 1.f; }
  else { mn = fmaxf(m_reg, pmax); alpha = __builtin_amdgcn_exp2f((m_reg - mn) * C); m_reg = mn; }
  const float mnC = -mn * C;
#pragma unroll
  for (int r = 0; r < 16; ++r) p0[r] = fmaf(p0[r], C, mnC);
#pragma unroll
  for (int r = 0; r < 16; ++r) p1[r] = fmaf(p1[r], C, mnC);
#pragma unroll
  for (int r = 0; r < 16; ++r) p0[r] = __builtin_amdgcn_exp2f(p0[r]);
}
__device__ __forceinline__ void finishSM(f32x16& p0, f32x16& p1, float alpha, float& l_reg, bf16x8& pa0, bf16x8& pa1, bf16x8& pa2, bf16x8& pa3) {
#pragma unroll
  for (int r = 0; r < 16; ++r) p1[r] = __builtin_amdgcn_exp2f(p1[r]);
  float ps = 0;
#pragma unroll
  for (int r = 0; r < 16; ++r) ps += p0[r];
#pragma unroll
  for (int r = 0; r < 16; ++r) ps += p1[r];
  { auto rr = __builtin_amdgcn_permlane32_swap(__float_as_uint(ps), __float_as_uint(ps), false, false);
    ps = __uint_as_float(rr[0]) + __uint_as_float(rr[1]); }
  l_reg = l_reg * alpha + ps;
#define PK4(P, BASE, OUT) do { unsigned a0 = cvtpk(P[BASE + 0], P[BASE + 1]), a1 = cvtpk(P[BASE + 2], P[BASE + 3]);   \
    unsigned b0 = cvtpk(P[BASE + 4], P[BASE + 5]), b1 = cvtpk(P[BASE + 6], P[BASE + 7]);                              \
    auto r0 = __builtin_amdgcn_permlane32_swap(a0, b0, false, false); auto r1 = __builtin_amdgcn_permlane32_swap(a1, b1, false, false); \
    u32x4 w = {r0[0], r1[0], r0[1], r1[1]}; OUT = __builtin_bit_cast(bf16x8, w); } while (0)
  PK4(p0, 0, pa0); PK4(p0, 8, pa1); PK4(p1, 0, pa2); PK4(p1, 8, pa3);
#undef PK4
}
#ifndef ATT_NQL
#define ATT_NQL 4
#endif
constexpr int NQL = ATT_NQL;
constexpr int OFF_QL = OFF_WS + 2048;
#define QFRAG(d) ((d) < 12 - NQL ? qr[(d)] : *(const LAS bf16x8*)(ql + ((d) - (12 - NQL)) * 1024))
template <int MODE> __device__ __forceinline__ void qkt(f32x16& p0, f32x16& p1, const LAS unsigned char* Kb, const bf16x8* qr, const LAS unsigned char* ql, int r32, int hi) {
  p0 = f32x16{}; p1 = f32x16{};
  if (MODE == 0) {
#pragma unroll
    for (int d0 = 0; d0 < 4; ++d0) { const int off = r32 * 128 + (((d0 * 2 + hi) ^ ((r32 >> 1) & 7)) << 4);
      const bf16x8 b0 = *(const LAS bf16x8*)(Kb + off), b1 = *(const LAS bf16x8*)(Kb + off + 4096);
      p0 = __builtin_amdgcn_mfma_f32_32x32x16_bf16(b0, qr[d0], p0, 0, 0, 0); p1 = __builtin_amdgcn_mfma_f32_32x32x16_bf16(b1, qr[d0], p1, 0, 0, 0); }
  } else {
#pragma unroll
    for (int d0 = 0; d0 < 8; ++d0) { const int off = r32 * 256 + (((d0 * 2 + hi) ^ (r32 & 15)) << 4);
      const bf16x8 b0 = *(const LAS bf16x8*)(Kb + off), b1 = *(const LAS bf16x8*)(Kb + off + 8192);
      const bf16x8 qf = QFRAG(d0); p0 = __builtin_amdgcn_mfma_f32_32x32x16_bf16(b0, qf, p0, 0, 0, 0); p1 = __builtin_amdgcn_mfma_f32_32x32x16_bf16(b1, qf, p1, 0, 0, 0); }
#pragma unroll
    for (int d0 = 0; d0 < 4; ++d0) { const int off = OFF_KR + r32 * 128 + (((d0 * 2 + hi) ^ ((r32 >> 1) & 7)) << 4);
      const bf16x8 b0 = *(const LAS bf16x8*)(Kb + off), b1 = *(const LAS bf16x8*)(Kb + off + 4096);
      const bf16x8 qf = QFRAG(8 + d0); p0 = __builtin_amdgcn_mfma_f32_32x32x16_bf16(b0, qf, p0, 0, 0, 0); p1 = __builtin_amdgcn_mfma_f32_32x32x16_bf16(b1, qf, p1, 0, 0, 0); }
  }
}
__device__ __forceinline__ int v_st(int k, int c) { const int kk = (k & ~0xC) | ((k & 4) << 1) | ((k & 8) >> 1); return ((kk >> 3) * 4 + (c >> 5)) * 512 + ((kk & 7) * 32 + (c & 31)) * 2; }
__device__ __forceinline__ int v_rd_base(int lane) { return ((lane & 3) << 3) | (((lane >> 2) & 3) << 6) | (((lane >> 4) & 1) << 5) | (((lane >> 5) & 1) << 8); }
constexpr int v_rd_off(int d0, int ks, int half) { return d0 * 512 + ks * 4096 + half * 2048; }
template <int OFF> __device__ __forceinline__ s16x4 tr_read(int vb) { s16x4 r; asm volatile("ds_read_b64_tr_b16 %0, %1 offset:%2" : "=&v"(r) : "v"(vb), "i"(OFF) : "memory"); return r; }
template <int D0> __device__ __forceinline__ void pv_one(f32x16& od, int vb, bf16x8 pa0, bf16x8 pa1, bf16x8 pa2, bf16x8 pa3) {
  const s16x4 l0 = tr_read<v_rd_off(D0, 0, 0)>(vb), h0 = tr_read<v_rd_off(D0, 0, 1)>(vb), l1 = tr_read<v_rd_off(D0, 1, 0)>(vb), h1 = tr_read<v_rd_off(D0, 1, 1)>(vb);
  const s16x4 l2 = tr_read<v_rd_off(D0, 2, 0)>(vb), h2 = tr_read<v_rd_off(D0, 2, 1)>(vb), l3 = tr_read<v_rd_off(D0, 3, 0)>(vb), h3 = tr_read<v_rd_off(D0, 3, 1)>(vb);
  asm volatile("s_waitcnt lgkmcnt(0)" ::: "memory"); SBAR();
#define PK(L, H) (bf16x8){L[0], L[1], L[2], L[3], H[0], H[1], H[2], H[3]}
  od = __builtin_amdgcn_mfma_f32_32x32x16_bf16(pa0, PK(l0, h0), od, 0, 0, 0);
  od = __builtin_amdgcn_mfma_f32_32x32x16_bf16(pa1, PK(l1, h1), od, 0, 0, 0);
  od = __builtin_amdgcn_mfma_f32_32x32x16_bf16(pa2, PK(l2, h2), od, 0, 0, 0);
  od = __builtin_amdgcn_mfma_f32_32x32x16_bf16(pa3, PK(l3, h3), od, 0, 0, 0);
#undef PK
}
__device__ __forceinline__ void pv_d0(f32x16* o, int vb, bf16x8 pa0, bf16x8 pa1, bf16x8 pa2, bf16x8 pa3) {
  pv_one<0>(o[0], vb, pa0, pa1, pa2, pa3); pv_one<1>(o[1], vb, pa0, pa1, pa2, pa3); pv_one<2>(o[2], vb, pa0, pa1, pa2, pa3); pv_one<3>(o[3], vb, pa0, pa1, pa2, pa3);
}
template <int MODE, int SDEPTH>
__device__ __forceinline__ void attn_core(f32x16 (&o)[4], const bf16* __restrict__ Qw, const bf16* __restrict__ K1, const bf16* __restrict__ K2, const bf16* __restrict__ Vh,
                                          float qpos, float nslope, LAS unsigned char* lds) {
  constexpr int DQ = MODE == 0 ? 4 : 12, LDK1 = MODE == 0 ? 1024 : 2048, LDV = MODE == 0 ? 1024 : 2048, NLD = MODE == 0 ? 3 : 5;
  const int wid = __builtin_amdgcn_readfirstlane((int)threadIdx.x >> 6), lane = lane_id(), tid = wid * 64 + lane, r32 = lane & 31, hi = lane >> 5;
  LAS unsigned char* V_lds = lds; LAS unsigned char* K_lds = lds + OFF_K;
  LAS float* ws = (LAS float*)(lds + OFF_WS) + wid * 64; LAS float* li_l = ws; LAS float* al_l = ws + 32;
  const LAS float* kpl = (const LAS float*)(lds + OFF_KPOS) + 4 * hi;
  constexpr int DQR = MODE == 0 ? 4 : 12 - NQL;
  float m_reg = -1e30f, l_reg = 0; o[0] = f32x16{}; o[1] = f32x16{}; o[2] = f32x16{}; o[3] = f32x16{}; bf16x8 qr[DQR];
#pragma unroll
  for (int d0 = 0; d0 < DQR; ++d0) qr[d0] = *(const bf16x8*)(Qw + d0 * 16);
  const LAS unsigned char* ql = lds + OFF_QL + wid * (NQL * 1024) + lane * 16;
  if (MODE == 1) {
#pragma unroll
    for (int d0 = DQR; d0 < DQ; ++d0) *(LAS bf16x8*)(lds + OFF_QL + wid * (NQL * 1024) + lane * 16 + (d0 - DQR) * 1024) = *(const bf16x8*)(Qw + d0 * 16);
  }
  const int sr = tid >> 4, sc = (tid & 15) * 8, vst0 = v_st(sr, sc), vst1 = v_st(32 + sr, sc);
  const int kn0 = sr * 256 + (((tid & 15) ^ (sr & 15)) << 4), kn1 = kn0 + 32 * 256;
  const int kr_row = tid >> 3, kr_ch = tid & 7, krw = kr_row * 128 + ((kr_ch ^ ((kr_row >> 1) & 7)) << 4);
  const int vb0 = (int)(unsigned)(uintptr_t)V_lds + v_rd_base(lane);
  struct { bf16x8 vs0, vs1, k0, k1, k2; } sr_[SDEPTH];
  const unsigned voV = (unsigned)(sr * LDV + sc) * 2u, voK = MODE == 0 ? (unsigned)(kr_row * LDK1 + kr_ch * 8) * 2u : voV, voR = (unsigned)(kr_row * 64 + kr_ch * 8) * 2u;
  const char* Vb0 = (const char*)Vh; const char* Vb1 = Vb0 + (size_t)32 * LDV * 2; const char* Kb0 = (const char*)K1; const char* Kb1 = Kb0 + (size_t)32 * LDK1 * 2; const char* Rb0 = (const char*)K2;
#define SLOAD(i, kb) do { const size_t tv_ = (size_t)(kb) * LDV * 2, tk_ = (size_t)(kb) * LDK1 * 2; \
    sr_[i].vs0 = *(const bf16x8*)(Vb0 + tv_ + voV); sr_[i].vs1 = *(const bf16x8*)(Vb1 + tv_ + voV); \
    if (MODE == 0) { sr_[i].k0 = *(const bf16x8*)(Kb0 + tk_ + voK); } \
    else { sr_[i].k0 = *(const bf16x8*)(Kb0 + tk_ + voK); sr_[i].k1 = *(const bf16x8*)(Kb1 + tk_ + voK); sr_[i].k2 = *(const bf16x8*)(Rb0 + (size_t)(kb) * 128 + voR); } } while (0)
#define SWRITE(b, i) do { *(LAS bf16x8*)(V_lds + (b) * SHM_V + vst0) = sr_[i].vs0; *(LAS bf16x8*)(V_lds + (b) * SHM_V + vst1) = sr_[i].vs1; \
    if (MODE == 0) { *(LAS bf16x8*)(K_lds + (b) * KBUF + krw) = sr_[i].k0; } \
    else { *(LAS bf16x8*)(K_lds + (b) * KBUF + kn0) = sr_[i].k0; *(LAS bf16x8*)(K_lds + (b) * KBUF + kn1) = sr_[i].k1; *(LAS bf16x8*)(K_lds + (b) * KBUF + OFF_KR + krw) = sr_[i].k2; } } while (0)
#define SWAIT() do { if constexpr (SDEPTH == 2) { if (MODE == 0) asm volatile("s_waitcnt vmcnt(3)" ::: "memory"); else asm volatile("s_waitcnt vmcnt(5)" ::: "memory"); } else asm volatile("s_waitcnt vmcnt(0)" ::: "memory"); } while (0)
#define RESC(a) do { if (__any((a) < 1.f)) { if (hi == 0) al_l[r32] = (a); asm volatile("s_waitcnt lgkmcnt(0)" ::: "memory"); \
    _Pragma("unroll") for (int d = 0; d < 4; ++d) _Pragma("unroll") for (int r = 0; r < 16; ++r) o[d][r] *= al_l[crow(r, hi)]; } } while (0)
  f32x16 pA0, pA1, pB0, pB1; float mnA, mnB, alA, alB; bf16x8 pa0, pa1, pa2, pa3; constexpr int NT = SEQ / 64;
  constexpr int SE = 0, SO = SDEPTH - 1;
  (void)NLD;
  SLOAD(SE, 0); asm volatile("s_waitcnt vmcnt(0)" ::: "memory"); SWRITE(0, SE); __syncthreads();
  qkt<MODE>(pA0, pA1, K_lds, qr, ql, r32, hi); partialSM<MODE>(pA0, pA1, m_reg, mnA, alA, qpos, nslope, kpl);
  SLOAD(SO, 64); if constexpr (SDEPTH == 2) { SLOAD(SE, 2 * 64); }
  SWAIT(); SWRITE(1, SO); __syncthreads();
#pragma unroll 1
  for (int j = 1; j + 1 < NT; j += 2) {
    SBAR(); qkt<MODE>(pB0, pB1, K_lds + KBUF, qr, ql, r32, hi);
    finishSM(pA0, pA1, alA, l_reg, pa0, pa1, pa2, pa3); SBAR();
    SLOAD(SO, (j + SDEPTH) * 64); SBAR();
    pv_d0(o, vb0, pa0, pa1, pa2, pa3); partialSM<MODE>(pB0, pB1, m_reg, mnB, alB, qpos, nslope, kpl + j * 64);
    __syncthreads(); SWAIT(); SWRITE(0, SE);
    RESC(alB); __syncthreads();
    SBAR(); qkt<MODE>(pA0, pA1, K_lds, qr, ql, r32, hi);
    finishSM(pB0, pB1, alB, l_reg, pa0, pa1, pa2, pa3); SBAR();
    if (SDEPTH == 1 || j + 3 < NT) SLOAD(SE, (j + 1 + SDEPTH) * 64); SBAR();
    pv_d0(o, vb0 + SHM_V, pa0, pa1, pa2, pa3); partialSM<MODE>(pA0, pA1, m_reg, mnA, alA, qpos, nslope, kpl + (j + 1) * 64);
    __syncthreads(); SWAIT(); SWRITE(1, SO);
    RESC(alA); __syncthreads();
  }
  SBAR(); qkt<MODE>(pB0, pB1, K_lds + KBUF, qr, ql, r32, hi);
  finishSM(pA0, pA1, alA, l_reg, pa0, pa1, pa2, pa3); SBAR();
  pv_d0(o, vb0, pa0, pa1, pa2, pa3); partialSM<MODE>(pB0, pB1, m_reg, mnB, alB, qpos, nslope, kpl + (NT - 1) * 64);
  __syncthreads(); RESC(alB);
  finishSM(pB0, pB1, alB, l_reg, pa0, pa1, pa2, pa3); SBAR();
  pv_d0(o, vb0 + SHM_V, pa0, pa1, pa2, pa3);
  if (hi == 0) li_l[r32] = l_reg; asm volatile("s_waitcnt lgkmcnt(0)" ::: "memory");
#pragma unroll
  for (int r = 0; r < 16; ++r) { const float rl = __builtin_amdgcn_rcpf(li_l[crow(r, hi)]);
#pragma unroll
    for (int d0 = 0; d0 < 4; ++d0) o[d0][r] *= rl; }
#undef SLOAD
#undef SWRITE
#undef SWAIT
#undef RESC
}
#undef SBAR
}

#ifndef ATT_SDEPTH0
#define ATT_SDEPTH0 2
#endif
#ifndef ATT_SDEPTH1
#define ATT_SDEPTH1 1
#endif
__device__ __forceinline__ void p3_fast(Frame& F) {
    using att::f32x16; using att::crow;
    LAS unsigned char* lds = F.lds;
    const int wid = F.wave;
    const float lam = lambda_full(F);
#ifndef ATT_SKIP_A
    const int nUA = (512 - F.vcu + F.G - 1) / F.G;
#pragma unroll 1
    for (int v = 0; v < 2 * nUA * REP_P3A; ++v) {
        const int u = F.vcu + ((v >> 1) % nUA) * F.G, map = v & 1;
        const int bh = u >> 4, qb = u & 15, b = bh >> 3, h = bh & 7; const size_t tok0 = (size_t)b * SEQ; const int q0 = qb * 256;
        const int lane = lane_id(), tid = wid * 64 + lane, r32 = lane & 31, hi = lane >> 5;
        __syncthreads();
        if (map == 0) { LAS float* kp = (LAS float*)(lds + att::OFF_KPOS); const int* ps = IN_POS(F) + tok0; for (int i = tid; i < SEQ; i += NWAVES * 64) kp[i] = (float)ps[i]; }
        const int qrow = q0 + wid * 32 + r32; const float qpos = (float)IN_POS(F)[tok0 + qrow]; const float nslope = -exp2f(-(float)(h + 1)) * 8.0f;
        const bf16* Qw = W_AQ(F) + (tok0 + qrow) * 1024 + h * 128 + map * 64 + hi * 8;
        const bf16* Kh = W_AK(F) + tok0 * 1024 + h * 128 + map * 64; const bf16* Vh = W_AV(F) + tok0 * 1024 + h * 128;
        f32x16 o[4];
        att::attn_core<0, ATT_SDEPTH0>(o, Qw, Kh, nullptr, Vh, qpos, nslope, lds);
        float* stash = W_STASH(F) + ((size_t)blockIdx.x * 512 + tid) * 64;
        if (map == 0) {
#pragma unroll
            for (int d0 = 0; d0 < 4; ++d0)
#pragma unroll
                for (int g = 0; g < 4; ++g) *(f32x4*)(stash + d0 * 16 + 4 * g) = (f32x4){o[d0][4 * g], o[d0][4 * g + 1], o[d0][4 * g + 2], o[d0][4 * g + 3]};
        } else {
            int rb = q0 + wid * 32 + 4 * hi; asm volatile("" : "+v"(rb));
#pragma unroll
            for (int d0 = 0; d0 < 4; ++d0)
#pragma unroll
                for (int g = 0; g < 4; ++g) { const f32x4 t = *(const f32x4*)(stash + d0 * 16 + 4 * g);
#pragma unroll
                    for (int e = 0; e < 4; ++e) o[d0][4 * g + e] = t[e] - lam * o[d0][4 * g + e]; }
            float ss[16];
#pragma unroll
            for (int r = 0; r < 16; ++r) { float s = 0.f;
#pragma unroll
                for (int d0 = 0; d0 < 4; ++d0) s += o[d0][r] * o[d0][r];
                s += __shfl_xor(s, 1); s += __shfl_xor(s, 2); s += __shfl_xor(s, 4); s += __shfl_xor(s, 8); s += __shfl_xor(s, 16); ss[r] = s; }
            const float* sg = IN_SUBLNG(F); const bf16* ags = W_AGS(F); bf16* abin = W_ABIN(F);
            float gcol[4];
#pragma unroll
            for (int d0 = 0; d0 < 4; ++d0) gcol[d0] = sg[d0 * 32 + r32] * (1.f - LAM_INIT);
#pragma unroll
            for (int r = 0; r < 16; ++r) { const float rs = 1.0f / sqrtf(ss[r] * (1.f / 128.f) + SUBLN_EPS); const size_t row = tok0 + rb + (r & 3) + 8 * (r >> 2);
#pragma unroll
                for (int d0 = 0; d0 < 4; ++d0) { const int col = h * 128 + d0 * 32 + r32; abin[row * 2048 + col] = (bf16)f2bf(o[d0][r] * rs * gcol[d0] * bf2f(ags[row * 1024 + col])); } }
        }
    }
#endif
#ifndef ATT_SKIP_B
#pragma unroll 1
    for (int rep = 0; rep < REP_P3B; ++rep)
#pragma unroll 1
    for (int u = F.vcu; u < 512; u += F.G) {
        const int bh = u >> 4, qb = u & 15, b = bh >> 3, h = bh & 7; const size_t tok0 = (size_t)b * SEQ; const int q0 = qb * 256;
        const int lane = lane_id(), r32 = lane & 31, hi = lane >> 5;
        __syncthreads();
        const int qrow = q0 + wid * 32 + r32;
        const bf16* Qw = W_Q(F) + (tok0 + qrow) * NQ + h * 192 + hi * 8;
        const bf16* Kh = W_KV(F) + tok0 * NKV + h * 256; const bf16* Kr = W_KR(F) + tok0 * 64;
        f32x16 o[4];
        att::attn_core<1, ATT_SDEPTH1>(o, Qw, Kh, Kr, Kh + 128, 0.f, 0.f, lds);
        const bf16* bgs = W_BGS(F); bf16* abin = W_ABIN(F);
        int rb = q0 + wid * 32 + 4 * hi; asm volatile("" : "+v"(rb));
#pragma unroll
        for (int r = 0; r < 16; ++r) { const size_t row = tok0 + rb + (r & 3) + 8 * (r >> 2);
#pragma unroll
            for (int d0 = 0; d0 < 4; ++d0) { const int col = h * 128 + d0 * 32 + r32; abin[row * 2048 + 1024 + col] = (bf16)f2bf(o[d0][r] * bf2f(bgs[row * 1024 + col])); } }
    }
#endif
}

__device__ __forceinline__ void p6_final(Frame& F) {
    const int gw = F.vcu * NWAVES + F.wave, NGW = F.G * NWAVES, lane = lane_id();
    for (int m = gw; m < T; m += NGW) {
        float s = lane < 32 ? W_ROWSS(F)[(size_t)m * 32 + lane] : 0.f;
        s = wave_sum(s);
        const float rs = 1.0f / sqrtf(s * (1.f / DM) + NORM_EPS);
        f32x4* yr = (f32x4*)(F.out + (size_t)m * DM) + lane; const f32x4* gr = (const f32x4*)IN_FINALG(F) + lane;
#pragma unroll
        for (int j = 0; j < 8; ++j) { const f32x4 y = yr[64 * j], g = gr[64 * j]; yr[64 * j] = (f32x4){y.x * rs * g.x, y.y * rs * g.y, y.z * rs * g.z, y.w * rs * g.w}; }
    }
}

__global__ void __launch_bounds__(NWAVES * 64, 2) mk_fwd(Args args) {
    extern __shared__ __attribute__((aligned(16))) unsigned char lds[];
    Frame F;
    F.lds = (LAS unsigned char*)lds;
    F.MISC = (volatile LAS unsigned*)(F.lds + MISC_OFF);
    F.wave = __builtin_amdgcn_readfirstlane((int)threadIdx.x >> 6);
    F.G = gridDim.x; { const int bx = blockIdx.x; F.vcu = (F.G % 8 == 0) ? (bx % 8) * (F.G / 8) + bx / 8 : bx; }
    F.in = args.in; F.out = args.out; F.ws = args.ws;
    for (int u = threadIdx.x; u < (LDS_BYTES - LDSCTL_OFF) / 4; u += NWAVES * 64) ((LAS unsigned*)(F.lds + LDSCTL_OFF))[u] = 0u;
    __syncthreads();
    XcdBarrier bar; bar.bar = W_CTL(F) + CW_BAR + args.li * XCD_BAR_WORDS; bar.x = 0; bar.st = nullptr;
    if (MK_N_LAUNCHES != NPHASE) bar = xcd_barrier_post(W_CTL(F) + CW_BAR + args.li * XCD_BAR_WORDS, F.MISC + 8);
#define GRID_BAR() do { if (MK_N_LAUNCHES != NPHASE) xcd_barrier(bar); } while (0)
    const int lo = args.ph_lo, hi = args.ph_hi;
#define IN(k) (lo <= (k) && (k) < hi)
#define BOTH(k) (IN(k) && IN((k) + 1))
    const int gw = F.vcu * NWAVES + F.wave, NGW = F.G * NWAVES;

    if (IN(0)) { for (int rep = 0; rep < REP_P0; ++rep) p0_prologue(F); if (BOTH(0)) GRID_BAR(); }
    if (IN(1)) {
#if NAIVE_P1
        NEpiP1 e{F}; naive_gemm(W_XB(F), DM, W_WIN(F), DM, T, NP1, DM, e, gw, NGW, lane_id(), 0);
#else
        pg8::StaticOrder S; S.init(T, 40 * 256, F.G, (int)blockIdx.x); SrcPlain P{(const char*)W_XB(F), (const char*)W_WIN(F), (size_t)256 * DM * 2}; EpiP1 E{F};
        for (int rep = 0; rep < REP_P1; ++rep) pg8::gemm_phase(F.lds, DM, DM / 64, S, P, E);
        { OrderKR S2{F.G, F.vcu}; SrcKR P2{(const char*)W_XB(F), (const char*)W_WIN(F), (size_t)256 * DM * 2}; EpiKR E2{F}; pg8::gemm_phase(F.lds, DM, 8, S2, P2, E2); }
#endif
        if (BOTH(1)) GRID_BAR();
    }
    if (IN(2)) {
#if NAIVE_P2
        NEpiQ eq{F}; naive_gemm(W_CQ(F), 512, W_WUQ(F), 512, T, NQ, 512, eq, gw, NGW, lane_id(), 0);
        NEpiKV ek{F}; naive_gemm(W_CKV(F), 512, W_WUKV(F), 512, T, NKV, 512, ek, gw, NGW, lane_id(), 0);
#else
        kr_finish(F);
        pg8::StaticOrder S; S.init(T, NQ + NKV, F.G, (int)blockIdx.x); SrcP2 P{(const char*)W_CQ(F), (const char*)W_CKV(F), (const char*)W_WUQ(F), (const char*)W_WUKV(F), (size_t)256 * 512 * 2}; EpiP2 E{F};
        for (int rep = 0; rep < REP_P2; ++rep) pg8::gemm_phase(F.lds, 512, 8, S, P, E);
#endif
        if (BOTH(2)) GRID_BAR();
    }
    if (IN(3)) {
#if NAIVE_P3
        p3_naive(F);
#else
        p3_fast(F);
#endif
        if (BOTH(3)) GRID_BAR();
    }
    if (IN(4)) {
#if NAIVE_P4
        NEpiMerge e{F}; naive_gemm(W_ABIN(F), 2048, W_WOAB(F), 2048, T, DM, 2048, e, gw, NGW, lane_id(), 1024);
#else
        OrderP4 S; S.S.init(T, DM, F.G, (int)blockIdx.x); SrcP4 P{(const char*)W_ABIN(F), (const char*)W_WOAB(F), (size_t)256 * 2048 * 2}; EpiP4 E{F};
        for (int rep = 0; rep < REP_P4; ++rep) pg8::gemm_phase(F.lds, 2048, 16, S, P, E);
#endif
        if (BOTH(4)) GRID_BAR();
    }
    if (IN(5)) {
#if NAIVE_P5
        NEpiOut e{F}; naive_gemm(W_MERGED(F), 2048, W_WOUT(F), 2048, T, DM, 2048, e, gw, NGW, lane_id(), 0);
#else
        pg8::StaticOrder S; S.init(T, DM, F.G, (int)blockIdx.x); SrcPlain P{(const char*)W_MERGED(F), (const char*)W_WOUT(F), (size_t)256 * 2048 * 2}; EpiP5 E{F};
        for (int rep = 0; rep < REP_P5; ++rep) pg8::gemm_phase(F.lds, 2048, 32, S, P, E);
#endif
        if (BOTH(5)) GRID_BAR();
    }
    if (IN(6)) p6_final(F);
#undef IN
#undef BOTH
}

extern "C" void kernel_launch(void* const* d_in, const int* in_sizes, int n_in, void* d_out, int out_size, void* d_ws, size_t ws_size, hipStream_t stream) {
    static int grid = 0;
    if (grid == 0) {
        if (n_in != 17 || in_sizes[0] != T * DM || out_size != T * DM || ws_size < WS_END) { fprintf(stderr, "kernel_launch: unexpected shapes (n_in %d, in0 %d, out %d, ws %zu)\n", n_in, n_in > 0 ? in_sizes[0] : -1, out_size, ws_size); grid = -1; return; }
        int dev = 0, cus = 0, per_cu = 0;
        if (hipGetDevice(&dev) != hipSuccess || hipDeviceGetAttribute(&cus, hipDeviceAttributeMultiprocessorCount, dev) != hipSuccess) { grid = -1; return; }
        if (hipFuncSetAttribute((const void*)mk_fwd, hipFuncAttributeMaxDynamicSharedMemorySize, LDS_BYTES) != hipSuccess) { fprintf(stderr, "kernel_launch: hipFuncSetAttribute failed\n"); grid = -1; return; }
        if (hipOccupancyMaxActiveBlocksPerMultiprocessor(&per_cu, (const void*)mk_fwd, NWAVES * 64, LDS_BYTES) != hipSuccess || per_cu < 1) { fprintf(stderr, "kernel_launch: occupancy query reports %d blocks per CU\n", per_cu); }
        (void)hipGetLastError();
        grid = cus;
    }
    if (grid < 0) return;
    if (hipMemsetAsync((char*)d_ws + WS_CTL, 0, CTL_ZERO_BYTES, stream) != hipSuccess) { fprintf(stderr, "kernel_launch: memset failed\n"); return; }
    Args a{};
    for (int i = 0; i < 17; ++i) a.in[i] = d_in[i];
    a.out = (float*)d_out; a.ws = (unsigned char*)d_ws;
    for (int li = 0; li < MK_N_LAUNCHES; ++li) {
        if (MK_N_LAUNCHES == NPHASE) { a.ph_lo = li; a.ph_hi = li + 1; } else { a.ph_lo = li * NPHASE / MK_N_LAUNCHES; a.ph_hi = (li + 1) * NPHASE / MK_N_LAUNCHES; }
        a.li = li;
        hipLaunchKernelGGL(mk_fwd, dim3(grid), dim3(NWAVES * 64), LDS_BYTES, stream, a);
        const hipError_t le = hipPeekAtLastError();
        if (le != hipSuccess) { fprintf(stderr, "kernel_launch: launch %d failed: %s\n", li, hipGetErrorName(le)); break; }
    }
}
```

```cpp
#include <hip/hip_runtime.h>
#include <cstdio>
#include <cstdint>

#define GAS __attribute__((address_space(1)))
#define LAS __attribute__((address_space(3)))
typedef unsigned short bf16;
typedef short bf16x8 __attribute__((ext_vector_type(8)));
typedef float f32x4 __attribute__((ext_vector_type(4)));
typedef float f32x2 __attribute__((ext_vector_type(2)));
typedef unsigned u32x4 __attribute__((ext_vector_type(4)));
typedef unsigned u32x2 __attribute__((ext_vector_type(2)));

#ifndef MK_N_LAUNCHES
#define MK_N_LAUNCHES 1
#endif
#ifndef REP_P0
#define REP_P0 1
#endif
#ifndef REP_P1
#define REP_P1 1
#endif
#ifndef REP_P2
#define REP_P2 1
#endif
#ifndef REP_P3A
#define REP_P3A 1
#endif
#ifndef REP_P3B
#define REP_P3B 1
#endif
#ifndef REP_P4
#define REP_P4 1
#endif
#ifndef REP_P5
#define REP_P5 1
#endif
#ifndef REP_P6
#define REP_P6 1
#endif
#ifndef NAIVE_P1
#define NAIVE_P1 0
#endif
#ifndef NAIVE_P2
#define NAIVE_P2 0
#endif
#ifndef NAIVE_P3
#define NAIVE_P3 0
#endif
#ifndef NAIVE_P4
#define NAIVE_P4 0
#endif
#ifndef NAIVE_P5
#define NAIVE_P5 0
#endif

constexpr int NB = 4, SEQ = 4096, T = NB * SEQ, DM = 2048;
constexpr int IN_COLS = 10304;
constexpr int OFF_AQ = 0, OFF_AK = 1024, OFF_AV = 2048, OFF_AG = 3072, OFF_CQ = 4096, OFF_CKV = 4608, OFF_KR = 5120, OFF_BG = 5184, OFF_MG = 6208;
constexpr int NP1 = 41 * 256;
constexpr int NQ = 1536, NKV = 2048;
constexpr int NWAVES = 8, NPHASE = 7;
constexpr float NORM_EPS = 1e-6f, SUBLN_EPS = 1e-5f, LAM_INIT = 0.2f;

constexpr size_t MiB = 1u << 20;
constexpr size_t WS_CTL = 0, CTL_ZERO_BYTES = 1 * MiB;
constexpr size_t WS_RSTDX = 1 * MiB;
constexpr size_t WS_SSQQ = WS_RSTDX + 256 * 1024;
constexpr size_t WS_SSQKV = WS_SSQQ + 512 * 1024;
constexpr size_t WS_ROWSS = 3 * MiB;
constexpr size_t WS_CS = 5 * MiB;
constexpr size_t WS_WUQ = 9 * MiB;
constexpr size_t WS_WUKV = 11 * MiB;
constexpr size_t WS_WOAB = 13 * MiB;
constexpr size_t WS_WOUT = 21 * MiB;
constexpr size_t WS_KR = 29 * MiB;
constexpr size_t WS_XB = 32 * MiB;
constexpr size_t WS_KV = WS_XB;
constexpr size_t WS_WIN = 96 * MiB;
constexpr size_t WS_Q = WS_WIN;
constexpr size_t WS_AQ = 144 * MiB, WS_AK = 176 * MiB, WS_AV = 208 * MiB;
constexpr size_t WS_MERGED = WS_AQ;
constexpr size_t WS_CQ = 240 * MiB, WS_CKV = 256 * MiB;
constexpr size_t WS_R = 272 * MiB, WS_SB = 336 * MiB;
constexpr size_t WS_STASH = 400 * MiB;
constexpr size_t WS_KRP = WS_STASH;
constexpr size_t WS_END = 432 * MiB;
constexpr size_t DO_ABIN = 0, DO_AGS = 64 * MiB, DO_BGS = 96 * MiB;

constexpr int CW_TMO = 0, CW_CODE = 1, CW_BAR = 4096;

constexpr int RING_BYTES = 131072;
constexpr int LDSCTL_OFF = 150 * 1024, MISC_OFF = LDSCTL_OFF + 320;
constexpr int LDS_BYTES = 154624;

#define RLX_AGENT __ATOMIC_RELAXED, __HIP_MEMORY_SCOPE_AGENT
#define LDS_WAIT() asm volatile("s_waitcnt lgkmcnt(0)" ::: "memory")
#define VM_WAIT() asm volatile("s_waitcnt vmcnt(0)" ::: "memory")
__device__ __forceinline__ unsigned f2bf(float f) { unsigned u = __builtin_bit_cast(unsigned, f); return (u + 0x7fffu + ((u >> 16) & 1u)) >> 16; }
__device__ __forceinline__ unsigned pk2(float lo, float hi) { return f2bf(lo) | (f2bf(hi) << 16); }
__device__ __forceinline__ float bf2f(unsigned short b) { return __builtin_bit_cast(float, (unsigned)b << 16); }
__device__ __forceinline__ float bflo(unsigned w) { return __builtin_bit_cast(float, w << 16); }
__device__ __forceinline__ float bfhi(unsigned w) { return __builtin_bit_cast(float, w & 0xffff0000u); }
__device__ __forceinline__ float silu_f(float v) { return v / (1.f + __expf(-v)); }
__device__ __forceinline__ float sigm_f(float v) { return 1.f / (1.f + __expf(-v)); }
__device__ __forceinline__ int lane_id() { int l; asm volatile("v_mbcnt_lo_u32_b32 %0, -1, 0\n\tv_mbcnt_hi_u32_b32 %0, -1, %0" : "=v"(l)); return l; }
__device__ __forceinline__ float wave_sum(float v) {
#pragma unroll
    for (int o = 1; o < 64; o <<= 1) v += __shfl_xor(v, o);
    return v;
}
__device__ __forceinline__ float wave_max(float v) {
#pragma unroll
    for (int o = 1; o < 64; o <<= 1) v = fmaxf(v, __shfl_xor(v, o));
    return v;
}

#define XB_TMO      128
#define XB_XCNT(j)  (256  + 64 * (j))
#define XB_XSUB(j)  (1280 + 64 * (j))
#define XB_XGEN(j)  (2304 + 64 * (j))
#define XB_TOP      3328
#define XB_TOPGEN   3392
#define XCD_BAR_WORDS 3456
#define XB_SPIN_CAP (1u << 18)
__device__ __forceinline__ unsigned xb_ld(unsigned* p)              { return __hip_atomic_load(p, __ATOMIC_RELAXED, __HIP_MEMORY_SCOPE_AGENT); }
__device__ __forceinline__ unsigned xb_add(unsigned* p, unsigned v) { return __hip_atomic_fetch_add(p, v, __ATOMIC_RELAXED, __HIP_MEMORY_SCOPE_AGENT); }
__device__ __forceinline__ unsigned xb_xcc_id() { return (unsigned)__builtin_amdgcn_s_getreg((3 << 11) | 20) & 0xFu; }
#define XB_SPIN(cond, bar) do { unsigned _sp = 0; while (cond) { __builtin_amdgcn_s_sleep(1); \
    if ((++_sp & 255u) == 0u) { if (xb_ld(&(bar)[XB_TMO])) break; if (_sp > XB_SPIN_CAP) { atomicAdd(&(bar)[XB_TMO], 1u); break; } } } } while (0)
struct XcdBarrier { unsigned* bar; unsigned x; volatile LAS unsigned* st; };
__device__ __forceinline__ XcdBarrier xcd_barrier_post(unsigned* bar, volatile LAS unsigned* st) {
    XcdBarrier b; b.bar = bar; b.x = xb_xcc_id(); b.st = st;
    if (threadIdx.x == 0) (void)xb_add(&bar[XB_XCNT(b.x)], 1u);
    return b;
}
__device__ __forceinline__ void xcd_barrier_complete(unsigned* bar, unsigned x, unsigned& nloc, unsigned& nx) {
    const unsigned G = gridDim.x * gridDim.y * gridDim.z;
    unsigned sum, cnt, mine, sp = 0u;
    for (;;) {
        sum = 0u; cnt = 0u; mine = 0u;
#pragma unroll
        for (unsigned j = 0; j < 16; ++j) { const unsigned c = xb_ld(&bar[XB_XCNT(j)]); sum += c; cnt += (c > 0u) ? 1u : 0u; mine = (j == x) ? c : mine; }
        if (sum == G) break;
        __builtin_amdgcn_s_sleep(1);
        if ((++sp & 255u) == 0u) { if (xb_ld(&bar[XB_TMO])) break; if (sp > XB_SPIN_CAP) { atomicAdd(&bar[XB_TMO], 1u); break; } }
    }
    nloc = mine > 0u ? mine : 1u; nx = cnt > 0u ? cnt : 1u;
}
__device__ __forceinline__ void xcd_barrier(const XcdBarrier& b) {
    asm volatile("s_waitcnt vmcnt(0)" ::: "memory");
    __syncthreads();
    if (threadIdx.x == 0) {
        unsigned* bar = b.bar;
        __builtin_amdgcn_s_waitcnt(0);
        unsigned nloc = b.st[0], nx = b.st[1];
        if (nloc == 0u) { xcd_barrier_complete(bar, b.x, nloc, nx); b.st[0] = nloc; b.st[1] = nx; }
        const unsigned old = xb_add(&bar[XB_XSUB(b.x)], 1u);
        const unsigned gen = old / nloc;
        if (old + 1u == (gen + 1u) * nloc) {
            __builtin_amdgcn_fence(__ATOMIC_RELEASE, "agent");
            asm volatile("s_waitcnt vmcnt(0)" ::: "memory");
            const unsigned og = xb_add(&bar[XB_TOP], 1u);
            const unsigned tg = og / nx;
            if (og + 1u == (tg + 1u) * nx) xb_add(&bar[XB_TOPGEN], 1u);
            else XB_SPIN(xb_ld(&bar[XB_TOPGEN]) == tg, bar);
            __builtin_amdgcn_fence(__ATOMIC_ACQUIRE, "agent");
            xb_add(&bar[XB_XGEN(b.x)], 1u);
            asm volatile("s_waitcnt vmcnt(0)" ::: "memory");
        } else {
            XB_SPIN(xb_ld(&bar[XB_XGEN(b.x)]) == gen, bar);
            __builtin_amdgcn_fence(__ATOMIC_ACQUIRE, "agent");
            asm volatile("s_waitcnt vmcnt(0)" ::: "memory");
        }
    }
    __syncthreads();
}

struct Args { const void* in[17]; float* out; unsigned char* ws; int ph_lo, ph_hi, li, pad; };
struct Frame {
    LAS unsigned char* lds;
    volatile LAS unsigned* MISC;
    int wave, vcu, G;
    const void* const* in; float* out; unsigned char* ws;
};
#define IN_X(F)      ((const float*)(F).in[0])
#define IN_POS(F)    ((const int*)(F).in[1])
#define IN_NORMG(F)  ((const float*)(F).in[2])
#define IN_WIN(F)    ((const float*)(F).in[3])
#define IN_LQ1(F)    ((const float*)(F).in[4])
#define IN_LK1(F)    ((const float*)(F).in[5])
#define IN_LQ2(F)    ((const float*)(F).in[6])
#define IN_LK2(F)    ((const float*)(F).in[7])
#define IN_SUBLNG(F) ((const float*)(F).in[8])
#define IN_WOA(F)    ((const float*)(F).in[9])
#define IN_QNG(F)    ((const float*)(F).in[10])
#define IN_WUQ(F)    ((const float*)(F).in[11])
#define IN_KVNG(F)   ((const float*)(F).in[12])
#define IN_WUKV(F)   ((const float*)(F).in[13])
#define IN_WOB(F)    ((const float*)(F).in[14])
#define IN_WOUT(F)   ((const float*)(F).in[15])
#define IN_FINALG(F) ((const float*)(F).in[16])
#define W_CTL(F)    ((unsigned*)((F).ws + WS_CTL))
#define W_RSTDX(F)  ((float*)((F).ws + WS_RSTDX))
#define W_SSQQ(F)   ((float*)((F).ws + WS_SSQQ))
#define W_SSQKV(F)  ((float*)((F).ws + WS_SSQKV))
#define W_ROWSS(F)  ((float*)((F).ws + WS_ROWSS))
#define W_CS(F)     ((f32x2*)((F).ws + WS_CS))
#define W_WIN(F)    ((bf16*)((F).ws + WS_WIN))
#define W_WUQ(F)    ((bf16*)((F).ws + WS_WUQ))
#define W_WUKV(F)   ((bf16*)((F).ws + WS_WUKV))
#define W_WOAB(F)   ((bf16*)((F).ws + WS_WOAB))
#define W_WOUT(F)   ((bf16*)((F).ws + WS_WOUT))
#define W_KR(F)     ((bf16*)((F).ws + WS_KR))
#define W_XB(F)     ((bf16*)((F).ws + WS_XB))
#define W_KV(F)     ((bf16*)((F).ws + WS_KV))
#define W_Q(F)      ((bf16*)((F).ws + WS_Q))
#define W_AQ(F)     ((bf16*)((F).ws + WS_AQ))
#define W_AK(F)     ((bf16*)((F).ws + WS_AK))
#define W_AV(F)     ((bf16*)((F).ws + WS_AV))
#define W_MERGED(F) ((bf16*)((F).ws + WS_MERGED))
#define W_CQ(F)     ((bf16*)((F).ws + WS_CQ))
#define W_CKV(F)    ((bf16*)((F).ws + WS_CKV))
#define W_R(F)      ((bf16*)((F).ws + WS_R))
#define W_SB(F)     ((bf16*)((F).ws + WS_SB))
#define W_STASH(F)  ((float*)((F).ws + WS_STASH))
#define W_KRP(F)    ((float*)((F).ws + WS_KRP))
#define W_ABIN(F)   ((bf16*)((unsigned char*)(F).out + DO_ABIN))
#define W_AGS(F)    ((bf16*)((unsigned char*)(F).out + DO_AGS))
#define W_BGS(F)    ((bf16*)((unsigned char*)(F).out + DO_BGS))

__device__ __forceinline__ int win_src_col(int n) {
    const int t = n >> 8, c = n & 255;
    if (t < 20) return n;
    if (t < 24) return OFF_BG + (n - 5120);
    if (t < 40) { const int j = t - 24; return c < 128 ? OFF_MG + 128 * j + c : OFF_MG + 2048 + 128 * j + (c - 128); }
    if (c < 32) return OFF_KR + c;
    if (c >= 128 && c < 160) return OFF_KR + 32 + (c - 128);
    return -1;
}
__device__ __forceinline__ int wuq_src_col(int n) {
    const int t = n >> 8, c = n & 255;
    if (t < 4) return (2 * t + (c >> 7)) * 192 + (c & 127);
    const int u = t - 4, cc = c & 127, hh = 4 * u + (cc >> 5);
    return hh * 192 + 128 + (c >> 7) * 32 + (cc & 31);
}
__device__ __forceinline__ void p0_transpose_item(const float* W, int ldw, int src0, const float* gain, int k0, bf16* WT, int nrow0, int ldt, int kdst0, LAS float* scr, int lane) {
    const int kq = lane >> 3, n4 = (lane & 7) * 4;
    if (src0 >= 0) {
        f32x4 v[8];
#pragma unroll
        for (int i = 0; i < 8; ++i) v[i] = *(const f32x4*)(W + (size_t)(k0 + kq + 8 * i) * ldw + src0 + n4);
#pragma unroll
        for (int i = 0; i < 8; ++i) { const int kk = kq + 8 * i; const float g = gain ? gain[k0 + kk] : 1.f; LAS float* d = scr + kk * 33 + n4; d[0] = v[i].x * g; d[1] = v[i].y * g; d[2] = v[i].z * g; d[3] = v[i].w * g; }
    } else {
#pragma unroll
        for (int i = 0; i < 8; ++i) { LAS float* d = scr + (kq + 8 * i) * 33 + n4; d[0] = 0.f; d[1] = 0.f; d[2] = 0.f; d[3] = 0.f; }
    }
    LDS_WAIT(); asm volatile("" ::: "memory");
    const int c = lane & 7;
#pragma unroll
    for (int j = 0; j < 4; ++j) { const int n = (lane >> 3) + 8 * j; const LAS float* s = scr + (8 * c) * 33 + n;
        u32x4 o; o.x = pk2(s[0 * 33], s[1 * 33]); o.y = pk2(s[2 * 33], s[3 * 33]); o.z = pk2(s[4 * 33], s[5 * 33]); o.w = pk2(s[6 * 33], s[7 * 33]);
        *(u32x4*)(WT + (size_t)(nrow0 + n) * ldt + kdst0 + k0 + 8 * c) = o; }
    LDS_WAIT(); asm volatile("" ::: "memory");
}
__device__ __forceinline__ void p0_prologue(Frame& F) {
    LAS float* scr = (LAS float*)(F.lds + F.wave * 16384);
    const int gw = F.vcu * NWAVES + F.wave, NGW = F.G * NWAVES, lane = lane_id();
    constexpr int I_IN = (DM / 64) * (NP1 / 32), I_UQ = (512 / 64) * (NQ / 32), I_UKV = (512 / 64) * (NKV / 32), I_OA = (1024 / 64) * (DM / 32), I_OUT = (DM / 64) * (DM / 32);
    constexpr int NITEMS = I_IN + I_UQ + I_UKV + 2 * I_OA + I_OUT;
    for (int it = gw; it < NITEMS; it += NGW) {
        int r = it;
        if (r < I_IN) { const int nb = r % (NP1 / 32), kb = r / (NP1 / 32); p0_transpose_item(IN_WIN(F), IN_COLS, win_src_col(nb * 32), IN_NORMG(F), kb * 64, W_WIN(F), nb * 32, DM, 0, scr, lane); continue; } r -= I_IN;
        if (r < I_UQ) { const int nb = r % (NQ / 32), kb = r / (NQ / 32); p0_transpose_item(IN_WUQ(F), NQ, wuq_src_col(nb * 32), IN_QNG(F), kb * 64, W_WUQ(F), nb * 32, 512, 0, scr, lane); continue; } r -= I_UQ;
        if (r < I_UKV) { const int nb = r % (NKV / 32), kb = r / (NKV / 32); p0_transpose_item(IN_WUKV(F), NKV, nb * 32, IN_KVNG(F), kb * 64, W_WUKV(F), nb * 32, 512, 0, scr, lane); continue; } r -= I_UKV;
        if (r < I_OA) { const int nb = r % (DM / 32), kb = r / (DM / 32); p0_transpose_item(IN_WOA(F), DM, nb * 32, nullptr, kb * 64, W_WOAB(F), nb * 32, 2048, 0, scr, lane); continue; } r -= I_OA;
        if (r < I_OA) { const int nb = r % (DM / 32), kb = r / (DM / 32); p0_transpose_item(IN_WOB(F), DM, nb * 32, nullptr, kb * 64, W_WOAB(F), nb * 32, 2048, 1024, scr, lane); continue; } r -= I_OA;
        { const int nb = r % (DM / 32), kb = r / (DM / 32); p0_transpose_item(IN_WOUT(F), DM, nb * 32, nullptr, kb * 64, W_WOUT(F), nb * 32, 2048, 0, scr, lane); }
    }
    for (int m = gw; m < T; m += NGW) {
        const f32x4* xr = (const f32x4*)(IN_X(F) + (size_t)m * DM) + lane;
        f32x4 v[8]; float s = 0.f;
#pragma unroll
        for (int j = 0; j < 8; ++j) { v[j] = xr[64 * j]; s += (v[j].x * v[j].x + v[j].y * v[j].y) + (v[j].z * v[j].z + v[j].w * v[j].w); }
        s = wave_sum(s);
        if (lane == 0) W_RSTDX(F)[m] = 1.0f / sqrtf(s * (1.f / DM) + NORM_EPS);
        u32x2* o8 = (u32x2*)(W_XB(F) + (size_t)m * DM) + lane;
#pragma unroll
        for (int j = 0; j < 8; ++j) { u32x2 w; w.x = pk2(v[j].x, v[j].y); w.y = pk2(v[j].z, v[j].w); o8[64 * j] = w; }
    }
    for (int e = (F.vcu * NWAVES * 64 + F.wave * 64 + lane); e < T * 32; e += F.G * NWAVES * 64) {
        const int row = e >> 5, i = e & 31;
        const float inv = exp2f(-(float)i * (13.287712379549449f / 32.f));
        const float ang = (float)IN_POS(F)[row] * inv;
        const double a = (double)ang, n = __builtin_rint(a * 0.15915494309189535), rr = __builtin_fma(-n, 6.283185307179586, a);
        const float rf = (float)rr;
        W_CS(F)[e] = (f32x2){cosf(rf), sinf(rf)};
    }
}

template <class Epi> __device__ __forceinline__ void naive_gemm(const bf16* A, int lda, const bf16* Bt, int ldb, int M, int N, int K, const Epi& epi, int gw, int NGW, int lane, int kmid) {
    const int nN = N / 256, nU = (M / 16) * nN, fr = lane & 15, fq = lane >> 4;
    for (int u = gw; u < nU; u += NGW) {
        const int pn = u % nN, row0 = (u / nN) * 16;
        f32x4 acc[16];
#pragma unroll
        for (int t = 0; t < 16; ++t) acc[t] = (f32x4){0.f, 0.f, 0.f, 0.f};
        const bf16* ap = A + (size_t)(row0 + fr) * lda + 8 * fq; const bf16* bp = Bt + (size_t)(256 * pn + fr) * ldb + 8 * fq;
        for (int k0 = 0; k0 < K; k0 += 32) {
            if (kmid > 0 && k0 == kmid) epi.mid(acc, pn, row0, fr, fq);
            const bf16x8 a = *(const bf16x8*)(ap + k0);
#pragma unroll
            for (int t = 0; t < 16; ++t) { const bf16x8 b = *(const bf16x8*)(bp + (size_t)(16 * t) * ldb + k0); acc[t] = __builtin_amdgcn_mfma_f32_16x16x32_bf16(a, b, acc[t], 0, 0, 0); }
        }
        epi(acc, pn, row0, fr, fq);
    }
}
__device__ __forceinline__ float quad16_sum(float v) { v += __shfl_xor(v, 1); v += __shfl_xor(v, 2); v += __shfl_xor(v, 4); v += __shfl_xor(v, 8); return v; }
struct NEpiP1 {
    Frame F;
    __device__ __forceinline__ void mid(f32x4 (&)[16], int, int, int, int) const {}
    __device__ __forceinline__ void operator()(f32x4 (&acc)[16], int pn, int row0, int fr, int fq) const {
        const Frame& f = F;
#pragma unroll
        for (int i = 0; i < 4; ++i) {
            const int row = row0 + 4 * fq + i; const float rs = W_RSTDX(f)[row];
            if (pn < 16) {
                bf16* dst = pn < 4 ? W_AQ(f) : pn < 8 ? W_AK(f) : pn < 12 ? W_AV(f) : W_AGS(f); const int cb = (pn & 3) * 256 + fr;
#pragma unroll
                for (int t = 0; t < 16; ++t) { float v = acc[t][i] * rs; if (pn >= 12) v = silu_f(v); dst[(size_t)row * 1024 + cb + 16 * t] = (bf16)f2bf(v); }
            } else if (pn < 20) {
                bf16* dst = pn < 18 ? W_CQ(f) : W_CKV(f); float* ssq = pn < 18 ? W_SSQQ(f) : W_SSQKV(f); const int cb = (pn & 1) * 256 + fr; float s = 0.f;
#pragma unroll
                for (int t = 0; t < 16; ++t) { const float v = acc[t][i] * rs; s += v * v; dst[(size_t)row * 512 + cb + 16 * t] = (bf16)f2bf(v); }
                s = quad16_sum(s);
                if (fr < 4) ssq[(size_t)row * 8 + (pn & 1) * 4 + fr] = fr == 0 ? s : 0.f;
            } else if (pn < 24) {
                const int cb = (pn - 20) * 256 + fr;
#pragma unroll
                for (int t = 0; t < 16; ++t) W_BGS(f)[(size_t)row * 1024 + cb + 16 * t] = (bf16)f2bf(silu_f(acc[t][i] * rs));
            } else if (pn < 40) {
                const int cb = (pn - 24) * 128 + fr;
#pragma unroll
                for (int t = 0; t < 8; ++t) { const float sa = sigm_f(acc[t][i] * rs), sb = sigm_f(acc[t + 8][i] * rs);
                    W_R(f)[(size_t)row * 2048 + cb + 16 * t] = (bf16)f2bf(sa / sb); W_SB(f)[(size_t)row * 2048 + cb + 16 * t] = (bf16)f2bf(sb); }
            } else {
#pragma unroll
                for (int t = 0; t < 2; ++t) { const int c = 16 * t + fr; const float x1 = acc[t][i] * rs, x2 = acc[t + 8][i] * rs; const f32x2 cs = W_CS(f)[(size_t)row * 32 + c];
                    W_KR(f)[(size_t)row * 64 + c] = (bf16)f2bf(x1 * cs.x - x2 * cs.y); W_KR(f)[(size_t)row * 64 + 32 + c] = (bf16)f2bf(x1 * cs.y + x2 * cs.x); }
            }
        }
    }
};
__device__ __forceinline__ float rstd8(const float* p, float inv_n, float eps) { const f32x4 a = *(const f32x4*)p, b = *(const f32x4*)(p + 4); const float s = ((a.x + a.y) + (a.z + a.w)) + ((b.x + b.y) + (b.z + b.w)); return 1.0f / sqrtf(s * inv_n + eps); }
struct NEpiQ {
    Frame F;
    __device__ __forceinline__ void mid(f32x4 (&)[16], int, int, int, int) const {}
    __device__ __forceinline__ void operator()(f32x4 (&acc)[16], int pn, int row0, int fr, int fq) const {
        const Frame& f = F;
#pragma unroll
        for (int i = 0; i < 4; ++i) {
            const int row = row0 + 4 * fq + i; const float rs = rstd8(W_SSQQ(f) + (size_t)row * 8, 1.f / 512.f, NORM_EPS);
            if (pn < 4) {
#pragma unroll
                for (int t = 0; t < 16; ++t) { const int c = 16 * t + fr, head = 2 * pn + (c >> 7); W_Q(f)[(size_t)row * NQ + head * 192 + (c & 127)] = (bf16)f2bf(acc[t][i] * rs); }
            } else {
#pragma unroll
                for (int t = 0; t < 8; ++t) { const int c = 16 * t + fr, head = 4 * (pn - 4) + (c >> 5), ii = c & 31; const float x1 = acc[t][i] * rs, x2 = acc[t + 8][i] * rs; const f32x2 cs = W_CS(f)[(size_t)row * 32 + ii];
                    W_Q(f)[(size_t)row * NQ + head * 192 + 128 + ii] = (bf16)f2bf(x1 * cs.x - x2 * cs.y); W_Q(f)[(size_t)row * NQ + head * 192 + 160 + ii] = (bf16)f2bf(x1 * cs.y + x2 * cs.x); }
            }
        }
    }
};
struct NEpiKV {
    Frame F;
    __device__ __forceinline__ void mid(f32x4 (&)[16], int, int, int, int) const {}
    __device__ __forceinline__ void operator()(f32x4 (&acc)[16], int pn, int row0, int fr, int fq) const {
        const Frame& f = F;
#pragma unroll
        for (int i = 0; i < 4; ++i) {
            const int row = row0 + 4 * fq + i; const float rs = rstd8(W_SSQKV(f) + (size_t)row * 8, 1.f / 512.f, NORM_EPS);
#pragma unroll
            for (int t = 0; t < 16; ++t) W_KV(f)[(size_t)row * NKV + pn * 256 + 16 * t + fr] = (bf16)f2bf(acc[t][i] * rs);
        }
    }
};
struct NEpiMerge {
    Frame F;
    __device__ __forceinline__ void mid(f32x4 (&acc)[16], int pn, int row0, int fr, int fq) const {
        const Frame& f = F;
#pragma unroll
        for (int i = 0; i < 4; ++i) { const int row = row0 + 4 * fq + i;
#pragma unroll
            for (int t = 0; t < 16; ++t) acc[t][i] *= bf2f(W_R(f)[(size_t)row * 2048 + pn * 256 + 16 * t + fr]); }
    }
    __device__ __forceinline__ void operator()(f32x4 (&acc)[16], int pn, int row0, int fr, int fq) const {
        const Frame& f = F;
#pragma unroll
        for (int i = 0; i < 4; ++i) { const int row = row0 + 4 * fq + i;
#pragma unroll
            for (int t = 0; t < 16; ++t) { const size_t o = (size_t)row * 2048 + pn * 256 + 16 * t + fr; W_MERGED(f)[o] = (bf16)f2bf(acc[t][i] * bf2f(W_SB(f)[o])); } }
    }
};
struct NEpiOut {
    Frame F;
    __device__ __forceinline__ void mid(f32x4 (&)[16], int, int, int, int) const {}
    __device__ __forceinline__ void operator()(f32x4 (&acc)[16], int pn, int row0, int fr, int fq) const {
        const Frame& f = F;
#pragma unroll
        for (int i = 0; i < 4; ++i) { const int row = row0 + 4 * fq + i; float s = 0.f;
#pragma unroll
            for (int t = 0; t < 16; ++t) { const size_t o = (size_t)row * DM + pn * 256 + 16 * t + fr; const float y = IN_X(f)[o] + acc[t][i]; f.out[o] = y; s += y * y; }
            s = quad16_sum(s);
            if (fr < 4) W_ROWSS(f)[(size_t)row * 32 + pn * 4 + fr] = fr == 0 ? s : 0.f; }
    }
};

template <int DK1, int DK2> __device__ __forceinline__ f32x2 naive_attn_row(Frame& F, const bf16* qrow, const bf16* K1, int ldk1, const bf16* K2, int ldk2, const bf16* V, int ldv,
                                                                          float scale, float slope, float qpos, const int* kpos, LAS float* P, LAS float* qs) {
    const int lane = lane_id();
    for (int d = lane; d < DK1 + DK2; d += 64) qs[d] = bf2f(qrow[d]);
    LDS_WAIT(); asm volatile("" ::: "memory");
    float mx = -1e30f;
    for (int it = 0; it < SEQ / 64; ++it) {
        const int j = it * 64 + lane; float s = 0.f;
        const bf16* kp = K1 + (size_t)j * ldk1;
#pragma unroll
        for (int c = 0; c < DK1 / 8; ++c) { const u32x4 w = *(const u32x4*)(kp + 8 * c);
            s += qs[8 * c + 0] * bflo(w.x) + qs[8 * c + 1] * bfhi(w.x) + qs[8 * c + 2] * bflo(w.y) + qs[8 * c + 3] * bfhi(w.y) + qs[8 * c + 4] * bflo(w.z) + qs[8 * c + 5] * bfhi(w.z) + qs[8 * c + 6] * bflo(w.w) + qs[8 * c + 7] * bfhi(w.w); }
        if (DK2 > 0) { const bf16* kp2 = K2 + (size_t)j * ldk2;
#pragma unroll
            for (int c = 0; c < DK2 / 8; ++c) { const u32x4 w = *(const u32x4*)(kp2 + 8 * c); const LAS float* q2 = qs + DK1 + 8 * c;
                s += q2[0] * bflo(w.x) + q2[1] * bfhi(w.x) + q2[2] * bflo(w.y) + q2[3] * bfhi(w.y) + q2[4] * bflo(w.z) + q2[5] * bfhi(w.z) + q2[6] * bflo(w.w) + q2[7] * bfhi(w.w); } }
        s = s * scale - slope * fabsf(qpos - (float)kpos[j]);
        P[j] = s; mx = fmaxf(mx, s);
    }
    mx = wave_max(mx);
    LDS_WAIT(); asm volatile("" ::: "memory");
    float l = 0.f;
    for (int it = 0; it < SEQ / 64; ++it) { const int j = it * 64 + lane; const float p = __expf(P[j] - mx); P[j] = p; l += p; }
    l = wave_sum(l);
    LDS_WAIT(); asm volatile("" ::: "memory");
    float o0 = 0.f, o1 = 0.f; const bf16* vp = V + 2 * lane;
#pragma unroll 8
    for (int j = 0; j < SEQ; ++j) { const float p = P[j]; const unsigned w = *(const unsigned*)(vp + (size_t)j * ldv); o0 += p * bflo(w); o1 += p * bfhi(w); }
    LDS_WAIT(); asm volatile("" ::: "memory");
    const float il = 1.f / l;
    return (f32x2){o0 * il, o1 * il};
}
__device__ __forceinline__ float lambda_full(Frame& F) {
    const int lane = lane_id();
    const float a = wave_sum(IN_LQ1(F)[lane] * IN_LK1(F)[lane]), b = wave_sum(IN_LQ2(F)[lane] * IN_LK2(F)[lane]);
    return __expf(a) - __expf(b) + LAM_INIT;
}
__device__ __forceinline__ void p3_naive(Frame& F) {
    LAS float* P = (LAS float*)(F.lds) + F.wave * SEQ; LAS float* qs = (LAS float*)(F.lds + 131072) + F.wave * 192;
    const float lam = lambda_full(F); const int lane = lane_id();
    for (int u = F.vcu; u < NB * 8 * (SEQ / 8); u += F.G) {
        const int r8 = u % (SEQ / 8), bh = u / (SEQ / 8), h = bh % 8, b = bh / 8, row = b * SEQ + r8 * 8 + F.wave;
        const float slope = exp2f(-(float)(h + 1)), qpos = (float)IN_POS(F)[row]; const int* kpos = IN_POS(F) + b * SEQ;
        const bf16* kb = W_AK(F) + (size_t)b * SEQ * 1024 + h * 128; const bf16* vb = W_AV(F) + (size_t)b * SEQ * 1024 + h * 128; const bf16* qb = W_AQ(F) + (size_t)row * 1024 + h * 128;
        const f32x2 o1 = naive_attn_row<64, 0>(F, qb, kb, 1024, nullptr, 0, vb, 1024, 0.125f, slope, qpos, kpos, P, qs);
        const f32x2 o2 = naive_attn_row<64, 0>(F, qb + 64, kb + 64, 1024, nullptr, 0, vb, 1024, 0.125f, slope, qpos, kpos, P, qs);
        const float d0 = o1.x - lam * o2.x, d1 = o1.y - lam * o2.y;
        const float ss = wave_sum(d0 * d0 + d1 * d1), rs = 1.0f / sqrtf(ss * (1.f / 128.f) + SUBLN_EPS);
        const unsigned gw_ = *(const unsigned*)(W_AGS(F) + (size_t)row * 1024 + h * 128 + 2 * lane);
        const float y0 = d0 * rs * IN_SUBLNG(F)[2 * lane] * (1.f - LAM_INIT) * bflo(gw_), y1 = d1 * rs * IN_SUBLNG(F)[2 * lane + 1] * (1.f - LAM_INIT) * bfhi(gw_);
        *(unsigned*)(W_ABIN(F) + (size_t)row * 2048 + h * 128 + 2 * lane) = pk2(y0, y1);
    }
    for (int u = F.vcu; u < NB * 8 * (SEQ / 8); u += F.G) {
        const int r8 = u % (SEQ / 8), bh = u / (SEQ / 8), h = bh % 8, b = bh / 8, row = b * SEQ + r8 * 8 + F.wave;
        const bf16* kb = W_KV(F) + (size_t)b * SEQ * NKV + h * 256; const bf16* krb = W_KR(F) + (size_t)b * SEQ * 64; const bf16* qb = W_Q(F) + (size_t)row * NQ + h * 192;
        const f32x2 o = naive_attn_row<128, 64>(F, qb, kb, NKV, krb, 64, kb + 128, NKV, 0.07216878364870322f, 0.f, 0.f, IN_POS(F) + b * SEQ, P, qs);
        const unsigned gw_ = *(const unsigned*)(W_BGS(F) + (size_t)row * 1024 + h * 128 + 2 * lane);
        *(unsigned*)(W_ABIN(F) + (size_t)row * 2048 + 1024 + h * 128 + 2 * lane) = pk2(o.x * bflo(gw_), o.y * bfhi(gw_));
    }
}

namespace pg8 {
constexpr int BM = 256, BK = 64, HALF = 128, HTB = HALF * BK * 2, STAGE_BYTES = 8 * HTB, NXCD = 8, WGM = 8;
__host__ __device__ __forceinline__ int lds_byte(int r, int c) { const int st = (r >> 4) * 2 + (c >> 5), rr = r & 15, cc = c & 31, ob = rr * 64 + cc * 2; return st * 1024 + (ob ^ (((ob >> 9) & 1) << 5)); }
__host__ __device__ __forceinline__ void stage_rc(int b, int& R, int& C) { const int st = b / 1024, sb = b % 1024, swz = sb ^ (((sb >> 9) & 1) << 5); R = (st >> 1) * 16 + swz / 64; C = (st & 1) * 32 + (swz % 64) / 2; }
__host__ __device__ __forceinline__ int perm32(int rho) { const int n = rho >> 4, i = rho & 15; return 8 * (i >> 2) + 4 * n + (i & 3); }
struct Unit { int pm, pn, part; };
struct StaticOrder {
    int nM, nN, nwg, G, c;
    __device__ void init(int M, int N, int G_, int c_) { nM = M / BM; nN = N / BM; nwg = nM * nN; G = G_; c = c_; }
    __device__ bool next(int i, Unit& u) const {
        const long L = (long)i * G + c; if (L >= nwg) return false;
        int wgid = (int)L; { const int q = nwg / NXCD, r = nwg % NXCD, xcd = wgid % NXCD, off = wgid / NXCD; wgid = (xcd < r ? xcd * (q + 1) : r * (q + 1) + (xcd - r) * q) + off; }
        const int nig = WGM * nN, gid = wgid / nig, fm = gid * WGM, gsz = (nM - fm) < WGM ? (nM - fm) : WGM;
        u.pm = fm + ((wgid % nig) % gsz); u.pn = (wgid % nig) / gsz; u.part = 0; return true;
    }
};
__device__ __forceinline__ unsigned cvt_pk_bf16(float lo, float hi) { unsigned r; asm volatile("v_cvt_pk_bf16_f32 %0, %1, %2" : "=v"(r) : "v"(lo), "v"(hi)); return r; }
__device__ __forceinline__ u32x4 pack8(const f32x4 v0, const f32x4 v1) { u32x4 w; w.x = cvt_pk_bf16(v0[0], v0[1]); w.y = cvt_pk_bf16(v0[2], v0[3]); w.z = cvt_pk_bf16(v1[0], v1[1]); w.w = cvt_pk_bf16(v1[2], v1[3]); return w; }
__device__ __forceinline__ void unpack8(const u32x4 w, f32x4& v0, f32x4& v1) { v0 = (f32x4){bflo(w.x), bfhi(w.x), bflo(w.y), bfhi(w.y)}; v1 = (f32x4){bflo(w.z), bfhi(w.z), bflo(w.w), bfhi(w.w)}; }

template <class Epi, class Sched, class Src>
__device__ __forceinline__ void gemm_phase(LAS unsigned char* lds, const int K  , const int nt  , const Sched& S, const Src& P, const Epi& E) {
    const int wid = __builtin_amdgcn_readfirstlane((int)threadIdx.x >> 6), lane = lane_id(), tid = wid * 64 + lane, wr = wid >> 2, wc = wid & 3, fr = lane & 15, fq = lane >> 4;
    unsigned voffA[2], voffB[2];
#pragma unroll
    for (int i = 0; i < 2; ++i) { int R, C; stage_rc(tid * 16 + i * 8192, R, C); const int Rb = Epi::PERM ? ((R & ~31) + perm32(R & 31)) : R;
        voffA[i] = (unsigned)(R * K + C) * 2u; voffB[i] = (unsigned)(Rb * K + C) * 2u; }
    const size_t kstep = (size_t)(BK * 2);
    const size_t hstep = (size_t)HALF * K * 2;
    const unsigned ldsw = (unsigned)wid * 1024u;
    const int aoff = lds_byte(wr * 64 + fr, fq * 8), boff = lds_byte(wc * 32 + fr, fq * 8);
#define PG8_SA(b, h) (((b) * 2 + (h)) * HTB)
#define PG8_SB(b, h) ((4 + (b) * 2 + (h)) * HTB)
#define PG8_STAGE(bufoff, gbase, voff) do { _Pragma("unroll") for (int _i = 0; _i < 2; ++_i) \
        __builtin_amdgcn_global_load_lds((const unsigned*)((const char*)(gbase) + (voff)[_i]), (LAS unsigned*)(lds + (bufoff) + ldsw + _i * 8192), 16, 0, 0); } while (0)
#define PG8_LDA(dst, b, h) do { _Pragma("unroll") for (int m = 0; m < 4; ++m) _Pragma("unroll") for (int k = 0; k < 2; ++k) dst[m][k] = *(const LAS bf16x8*)(lds + PG8_SA(b, h) + aoff + m * 2048 + k * 1024); } while (0)
#define PG8_LDB(dst, b, h) do { _Pragma("unroll") for (int n = 0; n < 2; ++n) _Pragma("unroll") for (int k = 0; k < 2; ++k) dst[n][k] = *(const LAS bf16x8*)(lds + PG8_SB(b, h) + boff + n * 2048 + k * 1024); } while (0)
#define PG8_MMA(ai, bj, At, Bt) do { __builtin_amdgcn_s_setprio(1); _Pragma("unroll") for (int m = 0; m < 4; ++m) _Pragma("unroll") for (int n = 0; n < 2; ++n) _Pragma("unroll") for (int k = 0; k < 2; ++k) \
        acc[ai][bj][m][n] = __builtin_amdgcn_mfma_f32_16x16x32_bf16(Bt[n][k], At[m][k], acc[ai][bj][m][n], 0, 0, 0); __builtin_amdgcn_s_setprio(0); } while (0)
#define PG8_WAIT_V(n) asm volatile("s_waitcnt vmcnt(" #n ")" ::: "memory")
#define PG8_WAIT_L(n) asm volatile("s_waitcnt lgkmcnt(" #n ")" ::: "memory")
#define PG8_BAR __builtin_amdgcn_s_barrier()
#define PG8_SCHED __builtin_amdgcn_sched_barrier(0)
    Unit cur, nxt; int ui = 0;
    if (!S.next(0, cur)) return;
    f32x4 acc[2][2][4][2];
#pragma unroll
    for (int a = 0; a < 2; ++a)
#pragma unroll
        for (int b = 0; b < 2; ++b)
#pragma unroll
            for (int m = 0; m < 4; ++m)
#pragma unroll
                for (int n = 0; n < 2; ++n) acc[a][b][m][n] = (f32x4){0.f, 0.f, 0.f, 0.f};
    bf16x8 At[4][2], B0[2][2], B1[2][2];
    const char* cA = P.a(cur); const char* cB = P.b(cur);
    PG8_STAGE(PG8_SB(0, 0), cB, voffB); PG8_STAGE(PG8_SB(0, 1), cB + hstep, voffB); PG8_STAGE(PG8_SA(0, 0), cA, voffA); PG8_STAGE(PG8_SA(0, 1), cA + hstep, voffA);
    if (wr == 1) PG8_BAR;
    PG8_WAIT_V(2); PG8_BAR;
    PG8_STAGE(PG8_SB(1, 0), cB + kstep, voffB); PG8_STAGE(PG8_SA(1, 0), cA + kstep, voffA); PG8_STAGE(PG8_SB(1, 1), cB + hstep + kstep, voffB);
    PG8_WAIT_V(6); PG8_BAR;
    for (;;) {
        const bool has_next = S.next(ui + 1, nxt);
        const char* nA = has_next ? P.a(nxt) : cA; const char* nB = has_next ? P.b(nxt) : cB;
        for (int t = 0; t < nt; t += 2) {
            const bool last = (t == nt - 2);
            const char* a1 = cA + (size_t)(t + 1) * kstep;
            const char* a2 = last ? nA : cA + (size_t)(t + 2) * kstep; const char* b2 = last ? nB : cB + (size_t)(t + 2) * kstep;
            const char* a3 = a2 + kstep; const char* b3 = b2 + kstep;
            PG8_LDB(B0, 0, 0); PG8_LDB(B1, 0, 1); PG8_SCHED; PG8_LDA(At, 0, 0); PG8_STAGE(PG8_SA(1, 1), a1 + hstep, voffA);
            PG8_WAIT_V(8); PG8_WAIT_L(0); PG8_BAR; PG8_MMA(0, 0, At, B0); PG8_MMA(0, 1, At, B1); PG8_BAR; PG8_SCHED;
            PG8_LDA(At, 0, 1); PG8_STAGE(PG8_SB(0, 0), b2, voffB); PG8_STAGE(PG8_SB(0, 1), b2 + hstep, voffB); PG8_STAGE(PG8_SA(0, 0), a2, voffA);
            PG8_WAIT_V(8); PG8_WAIT_L(0); PG8_BAR; PG8_MMA(1, 0, At, B0); PG8_MMA(1, 1, At, B1); PG8_BAR; PG8_SCHED;
            PG8_LDB(B0, 1, 0); PG8_LDB(B1, 1, 1); PG8_SCHED; PG8_LDA(At, 1, 0); PG8_STAGE(PG8_SA(0, 1), a2 + hstep, voffA);
            PG8_WAIT_V(8); PG8_WAIT_L(0); PG8_BAR; PG8_MMA(0, 0, At, B0); PG8_MMA(0, 1, At, B1); PG8_BAR; PG8_SCHED;
            PG8_LDA(At, 1, 1); PG8_STAGE(PG8_SB(1, 0), b3, voffB); PG8_STAGE(PG8_SB(1, 1), b3 + hstep, voffB); PG8_STAGE(PG8_SA(1, 0), a3, voffA);
            PG8_WAIT_V(8); PG8_WAIT_L(0); PG8_BAR; PG8_MMA(1, 0, At, B0); PG8_MMA(1, 1, At, B1); PG8_BAR; PG8_SCHED;
        }
        if (wr == 0) PG8_BAR;
        E(acc, cur, wr, wc, fr, fq);
        if (!has_next) break;
        if (!Epi::keep(cur)) {
#pragma unroll
        for (int a = 0; a < 2; ++a)
#pragma unroll
            for (int b = 0; b < 2; ++b)
#pragma unroll
                for (int m = 0; m < 4; ++m)
#pragma unroll
                    for (int n = 0; n < 2; ++n) acc[a][b][m][n] = (f32x4){0.f, 0.f, 0.f, 0.f};
        }
        cur = nxt; cA = nA; cB = nB; ++ui;
        if (wr == 1) PG8_BAR;
    }
    PG8_WAIT_V(0);
    PG8_BAR;
#undef PG8_SA
#undef PG8_SB
#undef PG8_STAGE
#undef PG8_LDA
#undef PG8_LDB
#undef PG8_MMA
#undef PG8_WAIT_V
#undef PG8_WAIT_L
#undef PG8_BAR
#undef PG8_SCHED
}
}

struct SrcPlain { const char* A; const char* B; size_t tstep;
    __device__ __forceinline__ const char* a(const pg8::Unit& u) const { return A + (size_t)u.pm * tstep; }
    __device__ __forceinline__ const char* b(const pg8::Unit& u) const { return B + (size_t)u.pn * tstep; } };
struct SrcP2 { const char *A0, *A1, *B0, *B1; size_t tstep;
    __device__ __forceinline__ const char* a(const pg8::Unit& u) const { return (u.pn < 6 ? A0 : A1) + (size_t)u.pm * tstep; }
    __device__ __forceinline__ const char* b(const pg8::Unit& u) const { return u.pn < 6 ? B0 + (size_t)u.pn * tstep : B1 + (size_t)(u.pn - 6) * tstep; } };

__device__ __forceinline__ float fq_sum(float v) { v += __shfl_xor(v, 16); v += __shfl_xor(v, 32); return v; }
struct EpiP1 {
    static constexpr bool PERM = true; static __device__ __forceinline__ bool keep(const pg8::Unit&) { return false; }
    Frame F;
    __device__ __forceinline__ void operator()(f32x4 (&acc)[2][2][4][2], const pg8::Unit& u, int wr, int wc, int fr, int fq) const {
        const int pn = u.pn, row0 = u.pm * 256 + wr * 64 + fr, c8 = 32 * wc + 8 * fq;
        const float* rstd = W_RSTDX(F);
        if (pn < 16 || (pn >= 20 && pn < 24)) {
            bf16* dst; int cb; bool act = false;
            float osc = 1.f;
            if (pn < 4) { dst = W_AQ(F); cb = pn * 256; osc = 0.125f * 1.4426950408889634f;   } else if (pn < 8) { dst = W_AK(F); cb = (pn - 4) * 256; } else if (pn < 12) { dst = W_AV(F); cb = (pn - 8) * 256; }
            else if (pn < 16) { dst = W_AGS(F); cb = (pn - 12) * 256; act = true; } else { dst = W_BGS(F); cb = (pn - 20) * 256; act = true; }
#pragma unroll
            for (int ai = 0; ai < 2; ++ai)
#pragma unroll
                for (int m = 0; m < 4; ++m) { const int row = row0 + ai * 128 + m * 16; const float rs = rstd[row] * osc; bf16* rowp = dst + (size_t)row * 1024 + cb + c8;
#pragma unroll
                    for (int bj = 0; bj < 2; ++bj) { f32x4 v0 = acc[ai][bj][m][0] * rs, v1 = acc[ai][bj][m][1] * rs;
                        if (act) {
#pragma unroll
                            for (int e = 0; e < 4; ++e) { v0[e] = silu_f(v0[e]); v1[e] = silu_f(v1[e]); } }
                        *(u32x4*)(rowp + bj * 128) = pg8::pack8(v0, v1); } }
        } else if (pn < 20) {
            bf16* dst = pn < 18 ? W_CQ(F) : W_CKV(F); float* ssq = pn < 18 ? W_SSQQ(F) : W_SSQKV(F); const int cb = (pn & 1) * 256;
#pragma unroll
            for (int ai = 0; ai < 2; ++ai)
#pragma unroll
                for (int m = 0; m < 4; ++m) { const int row = row0 + ai * 128 + m * 16; const float rs = rstd[row]; bf16* rowp = dst + (size_t)row * 512 + cb + c8; float s = 0.f;
#pragma unroll
                    for (int bj = 0; bj < 2; ++bj) { const f32x4 v0 = acc[ai][bj][m][0] * rs, v1 = acc[ai][bj][m][1] * rs;
                        s += (v0[0] * v0[0] + v0[1] * v0[1]) + (v0[2] * v0[2] + v0[3] * v0[3]) + (v1[0] * v1[0] + v1[1] * v1[1]) + (v1[2] * v1[2] + v1[3] * v1[3]);
                        *(u32x4*)(rowp + bj * 128) = pg8::pack8(v0, v1); }
                    s = fq_sum(s);
                    if (fq == 0) ssq[(size_t)row * 8 + (pn & 1) * 4 + wc] = s; }
        } else if (pn < 40) {
            bf16* Rp = W_R(F); bf16* Sp = W_SB(F); const int cb = (pn - 24) * 128 + c8;
#pragma unroll
            for (int ai = 0; ai < 2; ++ai)
#pragma unroll
                for (int m = 0; m < 4; ++m) { const int row = row0 + ai * 128 + m * 16; const float rs = rstd[row]; f32x4 r0, r1, s0, s1;
#pragma unroll
                    for (int e = 0; e < 4; ++e) { const float sa0 = sigm_f(acc[ai][0][m][0][e] * rs), sb0 = sigm_f(acc[ai][1][m][0][e] * rs), sa1 = sigm_f(acc[ai][0][m][1][e] * rs), sb1 = sigm_f(acc[ai][1][m][1][e] * rs);
                        r0[e] = sa0 / sb0; s0[e] = sb0; r1[e] = sa1 / sb1; s1[e] = sb1; }
                    *(u32x4*)(Rp + (size_t)row * 2048 + cb) = pg8::pack8(r0, r1); *(u32x4*)(Sp + (size_t)row * 2048 + cb) = pg8::pack8(s0, s1); }
        }
    }
};
struct EpiKR {
    static constexpr bool PERM = true; static __device__ __forceinline__ bool keep(const pg8::Unit&) { return false; }
    Frame F;
    __device__ __forceinline__ void operator()(f32x4 (&acc)[2][2][4][2], const pg8::Unit& u, int wr, int wc, int fr, int fq) const {
        if (wc != 0) return;
        float* krp = W_KRP(F) + ((size_t)u.part * T + u.pm * 256 + wr * 64 + fr) * 64 + 8 * fq;
#pragma unroll
        for (int ai = 0; ai < 2; ++ai)
#pragma unroll
            for (int m = 0; m < 4; ++m)
#pragma unroll
                for (int bj = 0; bj < 2; ++bj)
#pragma unroll
                    for (int n = 0; n < 2; ++n) *(f32x4*)(krp + (size_t)(ai * 128 + m * 16) * 64 + bj * 32 + 4 * n) = acc[ai][bj][m][n];
    }
};
struct OrderKR { int G, c;
    __device__ bool next(int i, pg8::Unit& u) const { const int L = i * G + c; if (L >= 256) return false; u.pm = L >> 2; u.pn = 40; u.part = L & 3; return true; } };
struct SrcKR { const char* A; const char* B; size_t tstep;
    __device__ __forceinline__ const char* a(const pg8::Unit& u) const { return A + (size_t)u.pm * tstep + (size_t)u.part * 1024; }
    __device__ __forceinline__ const char* b(const pg8::Unit& u) const { return B + (size_t)40 * tstep + (size_t)u.part * 1024; } };
__device__ __forceinline__ void kr_finish(Frame& F) {
    const float* krp = W_KRP(F); const float* rstd = W_RSTDX(F); const f32x2* cs = W_CS(F); bf16* kr = W_KR(F);
    for (int e = (F.vcu * NWAVES + F.wave) * 64 + lane_id(); e < T * 32; e += F.G * NWAVES * 64) {
        const int row = e >> 5, i = e & 31; float x1 = 0.f, x2 = 0.f;
#pragma unroll
        for (int sl = 0; sl < 4; ++sl) { x1 += krp[((size_t)sl * T + row) * 64 + i]; x2 += krp[((size_t)sl * T + row) * 64 + 32 + i]; }
        const float rs = rstd[row]; x1 *= rs; x2 *= rs; const f32x2 c = cs[e];
        kr[(size_t)row * 64 + i] = (bf16)f2bf(x1 * c.x - x2 * c.y); kr[(size_t)row * 64 + 32 + i] = (bf16)f2bf(x1 * c.y + x2 * c.x);
    }
}
struct EpiP2 {
    static constexpr bool PERM = true; static __device__ __forceinline__ bool keep(const pg8::Unit&) { return false; }
    Frame F;
    __device__ __forceinline__ void operator()(f32x4 (&acc)[2][2][4][2], const pg8::Unit& u, int wr, int wc, int fr, int fq) const {
        const int pn = u.pn, row0 = u.pm * 256 + wr * 64 + fr, c8 = 32 * wc + 8 * fq;
        if (pn < 4) {
            bf16* q = W_Q(F); const float* ssq = W_SSQQ(F);
#pragma unroll
            for (int ai = 0; ai < 2; ++ai)
#pragma unroll
                for (int m = 0; m < 4; ++m) { const int row = row0 + ai * 128 + m * 16; const float rs = rstd8(ssq + (size_t)row * 8, 1.f / 512.f, NORM_EPS);
#pragma unroll
                    for (int bj = 0; bj < 2; ++bj) *(u32x4*)(q + (size_t)row * NQ + (2 * pn + bj) * 192 + c8) = pg8::pack8(acc[ai][bj][m][0] * rs, acc[ai][bj][m][1] * rs); }
        } else if (pn < 6) {
            bf16* q = W_Q(F); const float* ssq = W_SSQQ(F); const f32x2* cs = W_CS(F); const int head = 4 * (pn - 4) + wc;
#pragma unroll
            for (int ai = 0; ai < 2; ++ai)
#pragma unroll
                for (int m = 0; m < 4; ++m) { const int row = row0 + ai * 128 + m * 16; const float rs = rstd8(ssq + (size_t)row * 8, 1.f / 512.f, NORM_EPS); const f32x4* cp = (const f32x4*)(cs + (size_t)row * 32 + 8 * fq); f32x4 a0, a1, b0, b1;
#pragma unroll
                    for (int n = 0; n < 2; ++n) { const f32x4 x1 = acc[ai][0][m][n] * rs, x2 = acc[ai][1][m][n] * rs; const f32x4 c01 = cp[2 * n], c23 = cp[2 * n + 1];
                        f32x4 o1, o2;
                        o1[0] = x1[0] * c01[0] - x2[0] * c01[1]; o2[0] = x1[0] * c01[1] + x2[0] * c01[0]; o1[1] = x1[1] * c01[2] - x2[1] * c01[3]; o2[1] = x1[1] * c01[3] + x2[1] * c01[2];
                        o1[2] = x1[2] * c23[0] - x2[2] * c23[1]; o2[2] = x1[2] * c23[1] + x2[2] * c23[0]; o1[3] = x1[3] * c23[2] - x2[3] * c23[3]; o2[3] = x1[3] * c23[3] + x2[3] * c23[2];
                        if (n == 0) { a0 = o1; b0 = o2; } else { a1 = o1; b1 = o2; } }
                    *(u32x4*)(q + (size_t)row * NQ + head * 192 + 128 + 8 * fq) = pg8::pack8(a0, a1); *(u32x4*)(q + (size_t)row * NQ + head * 192 + 160 + 8 * fq) = pg8::pack8(b0, b1); }
        } else {
            bf16* kv = W_KV(F); const float* ssq = W_SSQKV(F);
#pragma unroll
            for (int ai = 0; ai < 2; ++ai)
#pragma unroll
                for (int m = 0; m < 4; ++m) { const int row = row0 + ai * 128 + m * 16; const float rs = rstd8(ssq + (size_t)row * 8, 1.f / 512.f, NORM_EPS);
#pragma unroll
                    for (int bj = 0; bj < 2; ++bj) *(u32x4*)(kv + (size_t)row * NKV + (pn - 6) * 256 + bj * 128 + c8) = pg8::pack8(acc[ai][bj][m][0] * rs, acc[ai][bj][m][1] * rs); }
        }
    }
};
struct EpiP4 {
    static constexpr bool PERM = true; static __device__ __forceinline__ bool keep(const pg8::Unit& u) { return u.part == 0; }
    Frame F;
    __device__ __forceinline__ void operator()(f32x4 (&acc)[2][2][4][2], const pg8::Unit& u, int wr, int wc, int fr, int fq) const {
        const size_t o0 = (size_t)(u.pm * 256 + wr * 64 + fr) * 2048 + u.pn * 256 + 32 * wc + 8 * fq;
        if (u.part == 0) {
            const bf16* Rp = W_R(F);
#pragma unroll
            for (int ai = 0; ai < 2; ++ai)
#pragma unroll
                for (int m = 0; m < 4; ++m) {
#pragma unroll
                    for (int bj = 0; bj < 2; ++bj) { const u32x4 w = *(const u32x4*)(Rp + o0 + (size_t)(ai * 128 + m * 16) * 2048 + bj * 128); f32x4 r0, r1; pg8::unpack8(w, r0, r1); acc[ai][bj][m][0] *= r0; acc[ai][bj][m][1] *= r1; }
                    if (m & 1) asm volatile("" ::: "memory"); }
        } else {
            const bf16* Sp = W_SB(F); bf16* Mp = W_MERGED(F);
#pragma unroll
            for (int ai = 0; ai < 2; ++ai)
#pragma unroll
                for (int m = 0; m < 4; ++m) {
#pragma unroll
                    for (int bj = 0; bj < 2; ++bj) { const size_t o = o0 + (size_t)(ai * 128 + m * 16) * 2048 + bj * 128; const u32x4 w = *(const u32x4*)(Sp + o); f32x4 s0, s1; pg8::unpack8(w, s0, s1);
                        *(u32x4*)(Mp + o) = pg8::pack8(acc[ai][bj][m][0] * s0, acc[ai][bj][m][1] * s1); }
                    if (m & 1) asm volatile("" ::: "memory"); }
        }
    }
};
struct OrderP4 { pg8::StaticOrder S;
    __device__ bool next(int i, pg8::Unit& u) const { if (!S.next(i >> 1, u)) return false; u.part = i & 1; return true; } };
struct SrcP4 { const char* A; const char* B; size_t tstep;
    __device__ __forceinline__ const char* a(const pg8::Unit& u) const { return A + (size_t)u.pm * tstep + (size_t)u.part * 2048; }
    __device__ __forceinline__ const char* b(const pg8::Unit& u) const { return B + (size_t)u.pn * tstep + (size_t)u.part * 2048; } };
struct EpiP5 {
    static constexpr bool PERM = false; static __device__ __forceinline__ bool keep(const pg8::Unit&) { return false; }
    Frame F;
    __device__ __forceinline__ void operator()(f32x4 (&acc)[2][2][4][2], const pg8::Unit& u, int wr, int wc, int fr, int fq) const {
        const int row0 = u.pm * 256 + wr * 64 + fr, col0 = u.pn * 256 + wc * 32 + 4 * fq; const float* x = IN_X(F); float* out = F.out; float* rowss = W_ROWSS(F);
#pragma unroll
        for (int ai = 0; ai < 2; ++ai)
#pragma unroll
            for (int m = 0; m < 4; ++m) { const int row = row0 + ai * 128 + m * 16; const size_t o = (size_t)row * DM + col0; float s = 0.f;
#pragma unroll
                for (int bj = 0; bj < 2; ++bj)
#pragma unroll
                    for (int n = 0; n < 2; ++n) { const f32x4 y = *(const f32x4*)(x + o + bj * 128 + n * 16) + acc[ai][bj][m][n]; *(f32x4*)(out + o + bj * 128 + n * 16) = y; s += (y[0] * y[0] + y[1] * y[1]) + (y[2] * y[2] + y[3] * y[3]); }
                s = fq_sum(s);
                if (fq == 0) rowss[(size_t)row * 32 + u.pn * 4 + wc] = s; }
    }
};

namespace att {
typedef float f32x16 __attribute__((ext_vector_type(16)));
typedef short s16x4 __attribute__((ext_vector_type(4)));
constexpr int SHM_V = 16384, KBUF = 24576, OFF_K = 2 * SHM_V, OFF_KR = 16384, OFF_WS = OFF_K + 2 * KBUF, OFF_KPOS = OFF_WS + 2048, ATT_LDS = OFF_KPOS + 65536;
constexpr float THR = 8.f;
#define SBAR() __builtin_amdgcn_sched_barrier(0)
__device__ __forceinline__ int crow(int r, int hi) { return (r & 3) + 8 * (r >> 2) + 4 * hi; }
__device__ __forceinline__ unsigned cvtpk(float lo, float hi) { unsigned r; asm volatile("v_cvt_pk_bf16_f32 %0, %1, %2" : "=v"(r) : "v"(lo), "v"(hi)); return r; }
template <int MODE> __device__ __forceinline__ void partialSM(f32x16& p0, f32x16& p1, float& m_reg, float& mn, float& alpha, float qpos, float nslope, const LAS float* kp) {
  constexpr float SCALE = MODE == 0 ? 0.125f : 0.07216878364870322f, C = SCALE * 1.4426950408889634f;
  if (MODE == 0) {
#pragma unroll
    for (int g = 0; g < 4; ++g) { const f32x4 ka = *(const LAS f32x4*)(kp + 8 * g), kb = *(const LAS f32x4*)(kp + 32 + 8 * g);
#pragma unroll
      for (int e = 0; e < 4; ++e) { p0[4 * g + e] = fmaf(nslope, fabsf(qpos - ka[e]), p0[4 * g + e]); p1[4 * g + e] = fmaf(nslope, fabsf(qpos - kb[e]), p1[4 * g + e]); } }
  }
  float pmax = p0[0];
#pragma unroll
  for (int r = 1; r < 16; ++r) pmax = fmaxf(pmax, p0[r]);
#pragma unroll
  for (int r = 0; r < 16; ++r) pmax = fmaxf(pmax, p1[r]);
  { auto rr = __builtin_amdgcn_permlane32_swap(__float_as_uint(pmax), __float_as_uint(pmax), false, false);
    pmax = fmaxf(__uint_as_float(rr[0]), __uint_as_float(rr[1])); }
  if (__builtin_expect(__all(pmax - m_reg <= THR / SCALE), 1)) { mn = m_reg; alpha = 1.f; }
  else { mn = fmaxf(m_reg, pmax); alpha = __builtin_amdgcn_exp2f((m_reg - mn) * C); m_reg = mn; }
  const float mnC = -mn * C;
#pragma unroll
  for (int r = 0; r < 16; ++r) p0[r] = fmaf(p0[r], C, mnC);
#pragma unroll
  for (int r = 0; r < 16; ++r) p1[r] = fmaf(p1[r], C, mnC);
#pragma unroll
  for (int r = 0; r < 16; ++r) p0[r] = __builtin_amdgcn_exp2f(p0[r]);
}
template <bool FIRST> __device__ __forceinline__ void partialSM0(f32x16& p0, f32x16& p1, float& mhat, f32x16& negm, float& l_reg, float& alpha, float qa, const LAS float* kp) {
  constexpr float THRL = 8.f;
#pragma unroll
  for (int g = 0; g < 4; ++g) { const f32x4 ka = *(const LAS f32x4*)(kp + 8 * g), kb = *(const LAS f32x4*)(kp + 32 + 8 * g);
#pragma unroll
    for (int e = 0; e < 4; ++e) { p0[4 * g + e] -= fabsf(qa - ka[e]); p1[4 * g + e] -= fabsf(qa - kb[e]); } }
  float pmax = p0[0];
#pragma unroll
  for (int r = 1; r < 16; ++r) pmax = fmaxf(pmax, p0[r]);
#pragma unroll
  for (int r = 0; r < 16; ++r) pmax = fmaxf(pmax, p1[r]);
  { auto rr = __builtin_amdgcn_permlane32_swap(__float_as_uint(pmax), __float_as_uint(pmax), false, false);
    pmax = fmaxf(__uint_as_float(rr[0]), __uint_as_float(rr[1])); }
  alpha = 1.f;
  if (FIRST || __builtin_expect(__any(pmax > THRL), 0)) {
    const float dl = FIRST ? pmax : fmaxf(pmax, 0.f);
    mhat += dl;
#pragma unroll
    for (int r = 0; r < 16; ++r) { p0[r] -= dl; p1[r] -= dl; }
#pragma unroll
    for (int r = 0; r < 16; ++r) negm[r] = -mhat;
    if (!FIRST) { alpha = __builtin_amdgcn_exp2f(-dl); l_reg *= alpha; }
  }
#pragma unroll
  for (int r = 0; r < 16; ++r) p0[r] = __builtin_amdgcn_exp2f(p0[r]);
}
__device__ __forceinline__ void qkt0(f32x16& p0, f32x16& p1, const LAS unsigned char* Kb, const bf16x8* qr, const f32x16& negm, int r32, int hi) {
#pragma unroll
  for (int d0 = 0; d0 < 4; ++d0) { const int off = r32 * 128 + (((d0 * 2 + hi) ^ ((r32 >> 1) & 7)) << 4);
    const bf16x8 b0 = *(const LAS bf16x8*)(Kb + off), b1 = *(const LAS bf16x8*)(Kb + off + 4096);
    if (d0 == 0) { p0 = __builtin_amdgcn_mfma_f32_32x32x16_bf16(b0, qr[0], negm, 0, 0, 0); p1 = __builtin_amdgcn_mfma_f32_32x32x16_bf16(b1, qr[0], negm, 0, 0, 0); }
    else { p0 = __builtin_amdgcn_mfma_f32_32x32x16_bf16(b0, qr[d0], p0, 0, 0, 0); p1 = __builtin_amdgcn_mfma_f32_32x32x16_bf16(b1, qr[d0], p1, 0, 0, 0); } }
}
__device__ __forceinline__ void finishSM(f32x16& p0, f32x16& p1, float alpha, float& l_reg, bf16x8& pa0, bf16x8& pa1, bf16x8& pa2, bf16x8& pa3) {
#pragma unroll
  for (int r = 0; r < 16; ++r) p1[r] = __builtin_amdgcn_exp2f(p1[r]);
  float ps = 0;
#pragma unroll
  for (int r = 0; r < 16; ++r) ps += p0[r];
#pragma unroll
  for (int r = 0; r < 16; ++r) ps += p1[r];
  { auto rr = __builtin_amdgcn_permlane32_swap(__float_as_uint(ps), __float_as_uint(ps), false, false);
    ps = __uint_as_float(rr[0]) + __uint_as_float(rr[1]); }
  l_reg = l_reg * alpha + ps;
#define PK4(P, BASE, OUT) do { unsigned a0 = cvtpk(P[BASE + 0], P[BASE + 1]), a1 = cvtpk(P[BASE + 2], P[BASE + 3]);   \
    unsigned b0 = cvtpk(P[BASE + 4], P[BASE + 5]), b1 = cvtpk(P[BASE + 6], P[BASE + 7]);                              \
    auto r0 = __builtin_amdgcn_permlane32_swap(a0, b0, false, false); auto r1 = __builtin_amdgcn_permlane32_swap(a1, b1, false, false); \
    u32x4 w = {r0[0], r1[0], r0[1], r1[1]}; OUT = __builtin_bit_cast(bf16x8, w); } while (0)
  PK4(p0, 0, pa0); PK4(p0, 8, pa1); PK4(p1, 0, pa2); PK4(p1, 8, pa3);
#undef PK4
}
#ifndef ATT_NQL
#define ATT_NQL 4
#endif
constexpr int NQL = ATT_NQL;
constexpr int OFF_QL = OFF_WS + 2048;
#define QFRAG(d) ((d) < 12 - NQL ? qr[(d)] : *(const LAS bf16x8*)(ql + ((d) - (12 - NQL)) * 1024))
template <int MODE> __device__ __forceinline__ void qkt(f32x16& p0, f32x16& p1, const LAS unsigned char* Kb, const bf16x8* qr, const LAS unsigned char* ql, int r32, int hi) {
  p0 = f32x16{}; p1 = f32x16{};
  if (MODE == 0) {
#pragma unroll
    for (int d0 = 0; d0 < 4; ++d0) { const int off = r32 * 128 + (((d0 * 2 + hi) ^ ((r32 >> 1) & 7)) << 4);
      const bf16x8 b0 = *(const LAS bf16x8*)(Kb + off), b1 = *(const LAS bf16x8*)(Kb + off + 4096);
      p0 = __builtin_amdgcn_mfma_f32_32x32x16_bf16(b0, qr[d0], p0, 0, 0, 0); p1 = __builtin_amdgcn_mfma_f32_32x32x16_bf16(b1, qr[d0], p1, 0, 0, 0); }
  } else {
#pragma unroll
    for (int d0 = 0; d0 < 8; ++d0) { const int off = r32 * 256 + (((d0 * 2 + hi) ^ (r32 & 15)) << 4);
      const bf16x8 b0 = *(const LAS bf16x8*)(Kb + off), b1 = *(const LAS bf16x8*)(Kb + off + 8192);
      const bf16x8 qf = QFRAG(d0); p0 = __builtin_amdgcn_mfma_f32_32x32x16_bf16(b0, qf, p0, 0, 0, 0); p1 = __builtin_amdgcn_mfma_f32_32x32x16_bf16(b1, qf, p1, 0, 0, 0); }
#pragma unroll
    for (int d0 = 0; d0 < 4; ++d0) { const int off = OFF_KR + r32 * 128 + (((d0 * 2 + hi) ^ ((r32 >> 1) & 7)) << 4);
      const bf16x8 b0 = *(const LAS bf16x8*)(Kb + off), b1 = *(const LAS bf16x8*)(Kb + off + 4096);
      const bf16x8 qf = QFRAG(8 + d0); p0 = __builtin_amdgcn_mfma_f32_32x32x16_bf16(b0, qf, p0, 0, 0, 0); p1 = __builtin_amdgcn_mfma_f32_32x32x16_bf16(b1, qf, p1, 0, 0, 0); }
  }
}
__device__ __forceinline__ int v_st(int k, int c) { const int kk = (k & ~0xC) | ((k & 4) << 1) | ((k & 8) >> 1); return ((kk >> 3) * 4 + (c >> 5)) * 512 + ((kk & 7) * 32 + (c & 31)) * 2; }
__device__ __forceinline__ int v_rd_base(int lane) { return ((lane & 3) << 3) | (((lane >> 2) & 3) << 6) | (((lane >> 4) & 1) << 5) | (((lane >> 5) & 1) << 8); }
constexpr int v_rd_off(int d0, int ks, int half) { return d0 * 512 + ks * 4096 + half * 2048; }
template <int OFF> __device__ __forceinline__ s16x4 tr_read(int vb) { s16x4 r; asm volatile("ds_read_b64_tr_b16 %0, %1 offset:%2" : "=&v"(r) : "v"(vb), "i"(OFF) : "memory"); return r; }
template <int D0> __device__ __forceinline__ void pv_one(f32x16& od, int vb, bf16x8 pa0, bf16x8 pa1, bf16x8 pa2, bf16x8 pa3) {
  const s16x4 l0 = tr_read<v_rd_off(D0, 0, 0)>(vb), h0 = tr_read<v_rd_off(D0, 0, 1)>(vb), l1 = tr_read<v_rd_off(D0, 1, 0)>(vb), h1 = tr_read<v_rd_off(D0, 1, 1)>(vb);
  const s16x4 l2 = tr_read<v_rd_off(D0, 2, 0)>(vb), h2 = tr_read<v_rd_off(D0, 2, 1)>(vb), l3 = tr_read<v_rd_off(D0, 3, 0)>(vb), h3 = tr_read<v_rd_off(D0, 3, 1)>(vb);
  asm volatile("s_waitcnt lgkmcnt(0)" ::: "memory"); SBAR();
#define PK(L, H) (bf16x8){L[0], L[1], L[2], L[3], H[0], H[1], H[2], H[3]}
  od = __builtin_amdgcn_mfma_f32_32x32x16_bf16(pa0, PK(l0, h0), od, 0, 0, 0);
  od = __builtin_amdgcn_mfma_f32_32x32x16_bf16(pa1, PK(l1, h1), od, 0, 0, 0);
  od = __builtin_amdgcn_mfma_f32_32x32x16_bf16(pa2, PK(l2, h2), od, 0, 0, 0);
  od = __builtin_amdgcn_mfma_f32_32x32x16_bf16(pa3, PK(l3, h3), od, 0, 0, 0);
#undef PK
}
__device__ __forceinline__ void pv_d0(f32x16* o, int vb, bf16x8 pa0, bf16x8 pa1, bf16x8 pa2, bf16x8 pa3) {
  pv_one<0>(o[0], vb, pa0, pa1, pa2, pa3); pv_one<1>(o[1], vb, pa0, pa1, pa2, pa3); pv_one<2>(o[2], vb, pa0, pa1, pa2, pa3); pv_one<3>(o[3], vb, pa0, pa1, pa2, pa3);
}
template <int MODE, int SDEPTH>
__device__ __forceinline__ void attn_core(f32x16 (&o)[4], const bf16* __restrict__ Qw, const bf16* __restrict__ K1, const bf16* __restrict__ K2, const bf16* __restrict__ Vh,
                                          float qpos, float nslope, LAS unsigned char* lds, const int t0  ) {
  constexpr int DQ = MODE == 0 ? 4 : 12, LDK1 = MODE == 0 ? 1024 : 2048, LDV = MODE == 0 ? 1024 : 2048, NLD = MODE == 0 ? 3 : 5;
  const int wid = __builtin_amdgcn_readfirstlane((int)threadIdx.x >> 6), lane = lane_id(), tid = wid * 64 + lane, r32 = lane & 31, hi = lane >> 5;
  LAS unsigned char* V_lds = lds; LAS unsigned char* K_lds = lds + OFF_K;
  LAS float* ws = (LAS float*)(lds + OFF_WS) + wid * 64; LAS float* li_l = ws; LAS float* al_l = ws + 32;
  const LAS float* kpl = (const LAS float*)(lds + OFF_KPOS) + 4 * hi;
  constexpr int DQR = MODE == 0 ? 4 : 12 - NQL;
  float m_reg = -1e30f, l_reg = 0; o[0] = f32x16{}; o[1] = f32x16{}; o[2] = f32x16{}; o[3] = f32x16{}; bf16x8 qr[DQR];
#pragma unroll
  for (int d0 = 0; d0 < DQR; ++d0) qr[d0] = *(const bf16x8*)(Qw + d0 * 16);
  const LAS unsigned char* ql = lds + OFF_QL + wid * (NQL * 1024) + lane * 16;
  if (MODE == 1) {
#pragma unroll
    for (int d0 = DQR; d0 < DQ; ++d0) *(LAS bf16x8*)(lds + OFF_QL + wid * (NQL * 1024) + lane * 16 + (d0 - DQR) * 1024) = *(const bf16x8*)(Qw + d0 * 16);
  }
  const int sr = tid >> 4, sc = (tid & 15) * 8, vst0 = v_st(sr, sc), vst1 = v_st(32 + sr, sc);
  const int kn0 = sr * 256 + (((tid & 15) ^ (sr & 15)) << 4), kn1 = kn0 + 32 * 256;
  const int kr_row = tid >> 3, kr_ch = tid & 7, krw = kr_row * 128 + ((kr_ch ^ ((kr_row >> 1) & 7)) << 4);
  const int vb0 = (int)(unsigned)(uintptr_t)V_lds + v_rd_base(lane);
  struct { bf16x8 vs0, vs1, k0, k1, k2; } sr_[SDEPTH];
  const unsigned voV = (unsigned)(sr * LDV + sc) * 2u, voK = MODE == 0 ? (unsigned)(kr_row * LDK1 + kr_ch * 8) * 2u : voV, voR = (unsigned)(kr_row * 64 + kr_ch * 8) * 2u;
  const char* Vb0 = (const char*)Vh; const char* Vb1 = Vb0 + (size_t)32 * LDV * 2; const char* Kb0 = (const char*)K1; const char* Kb1 = Kb0 + (size_t)32 * LDK1 * 2; const char* Rb0 = (const char*)K2;
#define SLOAD(i, kb) do { const size_t tv_ = (size_t)(kb) * LDV * 2, tk_ = (size_t)(kb) * LDK1 * 2; \
    sr_[i].vs0 = *(const bf16x8*)(Vb0 + tv_ + voV); sr_[i].vs1 = *(const bf16x8*)(Vb1 + tv_ + voV); \
    if (MODE == 0) { sr_[i].k0 = *(const bf16x8*)(Kb0 + tk_ + voK); } \
    else { sr_[i].k0 = *(const bf16x8*)(Kb0 + tk_ + voK); sr_[i].k1 = *(const bf16x8*)(Kb1 + tk_ + voK); sr_[i].k2 = *(const bf16x8*)(Rb0 + (size_t)(kb) * 128 + voR); } } while (0)
#define SWRITE(b, i) do { *(LAS bf16x8*)(V_lds + (b) * SHM_V + vst0) = sr_[i].vs0; *(LAS bf16x8*)(V_lds + (b) * SHM_V + vst1) = sr_[i].vs1; \
    if (MODE == 0) { *(LAS bf16x8*)(K_lds + (b) * KBUF + krw) = sr_[i].k0; } \
    else { *(LAS bf16x8*)(K_lds + (b) * KBUF + kn0) = sr_[i].k0; *(LAS bf16x8*)(K_lds + (b) * KBUF + kn1) = sr_[i].k1; *(LAS bf16x8*)(K_lds + (b) * KBUF + OFF_KR + krw) = sr_[i].k2; } } while (0)
#define SWAIT() do { if constexpr (SDEPTH == 2) { if (MODE == 0) asm volatile("s_waitcnt vmcnt(3)" ::: "memory"); else asm volatile("s_waitcnt vmcnt(5)" ::: "memory"); } else asm volatile("s_waitcnt vmcnt(0)" ::: "memory"); } while (0)
#define RESC(a) do { if (__any((a) < 1.f)) { if (hi == 0) al_l[r32] = (a); asm volatile("s_waitcnt lgkmcnt(0)" ::: "memory"); \
    _Pragma("unroll") for (int d = 0; d < 4; ++d) _Pragma("unroll") for (int r = 0; r < 16; ++r) o[d][r] *= al_l[crow(r, hi)]; } } while (0)
  f32x16 pA0, pA1, pB0, pB1; float mnA, mnB, alA, alB; bf16x8 pa0, pa1, pa2, pa3; constexpr int NT = SEQ / 64;
  constexpr int SE = 0, SO = SDEPTH - 1;
  (void)NLD; (void)mnA; (void)mnB; (void)nslope;
  f32x16 negm = f32x16{}; float mhat = 0.f;
#define TI(i) ((t0 + (i)) & (NT - 1))
#define QKT(P0, P1, KB) do { if constexpr (MODE == 0) qkt0(P0, P1, KB, qr, negm, r32, hi); else qkt<MODE>(P0, P1, KB, qr, ql, r32, hi); } while (0)
#define PSM(FIRST, P0, P1, MN, AL, i) do { if constexpr (MODE == 0) partialSM0<FIRST>(P0, P1, mhat, negm, l_reg, AL, qpos, kpl + TI(i) * 64); else partialSM<MODE>(P0, P1, m_reg, MN, AL, qpos, nslope, kpl); } while (0)
#define FSM(P0, P1, AL) do { if constexpr (MODE == 0) finishSM(P0, P1, 1.f, l_reg, pa0, pa1, pa2, pa3); else finishSM(P0, P1, AL, l_reg, pa0, pa1, pa2, pa3); } while (0)
  SLOAD(SE, TI(0) * 64); asm volatile("s_waitcnt vmcnt(0)" ::: "memory"); SWRITE(0, SE); __syncthreads();
  QKT(pA0, pA1, K_lds); PSM(true, pA0, pA1, mnA, alA, 0);
  SLOAD(SO, TI(1) * 64); if constexpr (SDEPTH == 2) { SLOAD(SE, TI(2) * 64); }
  SWAIT(); SWRITE(1, SO); __syncthreads();
#pragma unroll 1
  for (int j = 1; j + 1 < NT; j += 2) {
    SBAR(); QKT(pB0, pB1, K_lds + KBUF);
    FSM(pA0, pA1, alA); SBAR();
    SLOAD(SO, TI(j + SDEPTH) * 64); SBAR();
    pv_d0(o, vb0, pa0, pa1, pa2, pa3); PSM(false, pB0, pB1, mnB, alB, j);
    __syncthreads(); SWAIT(); SWRITE(0, SE);
    RESC(alB); __syncthreads();
    SBAR(); QKT(pA0, pA1, K_lds);
    FSM(pB0, pB1, alB); SBAR();
    if (SDEPTH == 1 || j + 3 < NT) SLOAD(SE, TI(j + 1 + SDEPTH) * 64); SBAR();
    pv_d0(o, vb0 + SHM_V, pa0, pa1, pa2, pa3); PSM(false, pA0, pA1, mnA, alA, j + 1);
    __syncthreads(); SWAIT(); SWRITE(1, SO);
    RESC(alA); __syncthreads();
  }
  SBAR(); QKT(pB0, pB1, K_lds + KBUF);
  FSM(pA0, pA1, alA); SBAR();
  pv_d0(o, vb0, pa0, pa1, pa2, pa3); PSM(false, pB0, pB1, mnB, alB, NT - 1);
  __syncthreads(); RESC(alB);
  FSM(pB0, pB1, alB); SBAR();
  pv_d0(o, vb0 + SHM_V, pa0, pa1, pa2, pa3);
#undef TI
#undef QKT
#undef PSM
#undef FSM
  if (hi == 0) li_l[r32] = l_reg; asm volatile("s_waitcnt lgkmcnt(0)" ::: "memory");
#pragma unroll
  for (int r = 0; r < 16; ++r) { const float rl = __builtin_amdgcn_rcpf(li_l[crow(r, hi)]);
#pragma unroll
    for (int d0 = 0; d0 < 4; ++d0) o[d0][r] *= rl; }
#undef SLOAD
#undef SWRITE
#undef SWAIT
#undef RESC
}
#undef SBAR
}

#ifndef ATT_SDEPTH0
#define ATT_SDEPTH0 2
#endif
#ifndef ATT_SDEPTH1
#define ATT_SDEPTH1 1
#endif
__device__ __forceinline__ void p3_fast(Frame& F) {
    using att::f32x16; using att::crow;
    LAS unsigned char* lds = F.lds;
    const int wid = F.wave;
    const float lam = lambda_full(F);
#ifndef ATT_SKIP_A
    const int nUA = (512 - F.vcu + F.G - 1) / F.G;
#pragma unroll 1
    for (int v = 0; v < 2 * nUA * REP_P3A; ++v) {
        const int u = F.vcu + ((v >> 1) % nUA) * F.G, map = v & 1;
        const int bh = u >> 4, qb = u & 15, b = bh >> 3, h = bh & 7; const size_t tok0 = (size_t)b * SEQ; const int q0 = qb * 256;
        const int lane = lane_id(), tid = wid * 64 + lane, r32 = lane & 31, hi = lane >> 5;
        __syncthreads();
        const float sl2 = exp2f(-(float)(h + 1)) * 1.4426950408889634f;
        if (map == 0) { LAS float* kp = (LAS float*)(lds + att::OFF_KPOS); const int* ps = IN_POS(F) + tok0; for (int i = tid; i < SEQ; i += NWAVES * 64) kp[i] = sl2 * (float)ps[i]; }
        const int qrow = q0 + wid * 32 + r32; const float qpos = sl2 * (float)IN_POS(F)[tok0 + qrow];
        const bf16* Qw = W_AQ(F) + (tok0 + qrow) * 1024 + h * 128 + map * 64 + hi * 8;
        const bf16* Kh = W_AK(F) + tok0 * 1024 + h * 128 + map * 64; const bf16* Vh = W_AV(F) + tok0 * 1024 + h * 128;
        f32x16 o[4];
        att::attn_core<0, ATT_SDEPTH0>(o, Qw, Kh, nullptr, Vh, qpos, 0.f, lds, 4 * qb);
        float* stash = W_STASH(F) + ((size_t)blockIdx.x * 512 + tid) * 64;
        if (map == 0) {
#pragma unroll
            for (int d0 = 0; d0 < 4; ++d0)
#pragma unroll
                for (int g = 0; g < 4; ++g) *(f32x4*)(stash + d0 * 16 + 4 * g) = (f32x4){o[d0][4 * g], o[d0][4 * g + 1], o[d0][4 * g + 2], o[d0][4 * g + 3]};
        } else {
            int rb = q0 + wid * 32 + 4 * hi; asm volatile("" : "+v"(rb));
#pragma unroll
            for (int d0 = 0; d0 < 4; ++d0)
#pragma unroll
                for (int g = 0; g < 4; ++g) { const f32x4 t = *(const f32x4*)(stash + d0 * 16 + 4 * g);
#pragma unroll
                    for (int e = 0; e < 4; ++e) o[d0][4 * g + e] = t[e] - lam * o[d0][4 * g + e]; }
            float ss[16];
#pragma unroll
            for (int r = 0; r < 16; ++r) { float s = 0.f;
#pragma unroll
                for (int d0 = 0; d0 < 4; ++d0) s += o[d0][r] * o[d0][r];
                s += __shfl_xor(s, 1); s += __shfl_xor(s, 2); s += __shfl_xor(s, 4); s += __shfl_xor(s, 8); s += __shfl_xor(s, 16); ss[r] = s; }
            const float* sg = IN_SUBLNG(F); const bf16* ags = W_AGS(F); bf16* abin = W_ABIN(F);
            float gcol[4];
#pragma unroll
            for (int d0 = 0; d0 < 4; ++d0) gcol[d0] = sg[d0 * 32 + r32] * (1.f - LAM_INIT);
#pragma unroll
            for (int r = 0; r < 16; ++r) { const float rs = 1.0f / sqrtf(ss[r] * (1.f / 128.f) + SUBLN_EPS); const size_t row = tok0 + rb + (r & 3) + 8 * (r >> 2);
#pragma unroll
                for (int d0 = 0; d0 < 4; ++d0) { const int col = h * 128 + d0 * 32 + r32; abin[row * 2048 + col] = (bf16)f2bf(o[d0][r] * rs * gcol[d0] * bf2f(ags[row * 1024 + col])); } }
        }
    }
#endif
#ifndef ATT_SKIP_B
#pragma unroll 1
    for (int rep = 0; rep < REP_P3B; ++rep)
#pragma unroll 1
    for (int u = F.vcu; u < 512; u += F.G) {
        const int bh = u >> 4, qb = u & 15, b = bh >> 3, h = bh & 7; const size_t tok0 = (size_t)b * SEQ; const int q0 = qb * 256;
        const int lane = lane_id(), r32 = lane & 31, hi = lane >> 5;
        __syncthreads();
        const int qrow = q0 + wid * 32 + r32;
        const bf16* Qw = W_Q(F) + (tok0 + qrow) * NQ + h * 192 + hi * 8;
        const bf16* Kh = W_KV(F) + tok0 * NKV + h * 256; const bf16* Kr = W_KR(F) + tok0 * 64;
        f32x16 o[4];
        att::attn_core<1, ATT_SDEPTH1>(o, Qw, Kh, Kr, Kh + 128, 0.f, 0.f, lds, 0);
        const bf16* bgs = W_BGS(F); bf16* abin = W_ABIN(F);
        int rb = q0 + wid * 32 + 4 * hi; asm volatile("" : "+v"(rb));
#pragma unroll
        for (int r = 0; r < 16; ++r) { const size_t row = tok0 + rb + (r & 3) + 8 * (r >> 2);
#pragma unroll
            for (int d0 = 0; d0 < 4; ++d0) { const int col = h * 128 + d0 * 32 + r32; abin[row * 2048 + 1024 + col] = (bf16)f2bf(o[d0][r] * bf2f(bgs[row * 1024 + col])); } }
    }
#endif
}

__device__ __forceinline__ void p6_final(Frame& F) {
    const int gw = F.vcu * NWAVES + F.wave, NGW = F.G * NWAVES, lane = lane_id();
    for (int m = gw; m < T; m += NGW) {
        float s = lane < 32 ? W_ROWSS(F)[(size_t)m * 32 + lane] : 0.f;
        s = wave_sum(s);
        const float rs = 1.0f / sqrtf(s * (1.f / DM) + NORM_EPS);
        f32x4* yr = (f32x4*)(F.out + (size_t)m * DM) + lane; const f32x4* gr = (const f32x4*)IN_FINALG(F) + lane;
#pragma unroll
        for (int j = 0; j < 8; ++j) { const f32x4 y = yr[64 * j], g = gr[64 * j]; yr[64 * j] = (f32x4){y.x * rs * g.x, y.y * rs * g.y, y.z * rs * g.z, y.w * rs * g.w}; }
    }
}

__global__ void __launch_bounds__(NWAVES * 64, 2) mk_fwd(Args args) {
    extern __shared__ __attribute__((aligned(16))) unsigned char lds[];
    Frame F;
    F.lds = (LAS unsigned char*)lds;
    F.MISC = (volatile LAS unsigned*)(F.lds + MISC_OFF);
    F.wave = __builtin_amdgcn_readfirstlane((int)threadIdx.x >> 6);
    F.G = gridDim.x; { const int bx = blockIdx.x; F.vcu = (F.G % 8 == 0) ? (bx % 8) * (F.G / 8) + bx / 8 : bx; }
    F.in = args.in; F.out = args.out; F.ws = args.ws;
    for (int u = threadIdx.x; u < (LDS_BYTES - LDSCTL_OFF) / 4; u += NWAVES * 64) ((LAS unsigned*)(F.lds + LDSCTL_OFF))[u] = 0u;
    __syncthreads();
    XcdBarrier bar; bar.bar = W_CTL(F) + CW_BAR + args.li * XCD_BAR_WORDS; bar.x = 0; bar.st = nullptr;
    if (MK_N_LAUNCHES != NPHASE) bar = xcd_barrier_post(W_CTL(F) + CW_BAR + args.li * XCD_BAR_WORDS, F.MISC + 8);
#define GRID_BAR() do { if (MK_N_LAUNCHES != NPHASE) xcd_barrier(bar); } while (0)
    const int lo = args.ph_lo, hi = args.ph_hi;
#define IN(k) (lo <= (k) && (k) < hi)
#define BOTH(k) (IN(k) && IN((k) + 1))
    const int gw = F.vcu * NWAVES + F.wave, NGW = F.G * NWAVES;

    if (IN(0)) { for (int rep = 0; rep < REP_P0; ++rep) p0_prologue(F); if (BOTH(0)) GRID_BAR(); }
    if (IN(1)) {
#if NAIVE_P1
        NEpiP1 e{F}; naive_gemm(W_XB(F), DM, W_WIN(F), DM, T, NP1, DM, e, gw, NGW, lane_id(), 0);
#else
        pg8::StaticOrder S; S.init(T, 40 * 256, F.G, (int)blockIdx.x); SrcPlain P{(const char*)W_XB(F), (const char*)W_WIN(F), (size_t)256 * DM * 2}; EpiP1 E{F};
        for (int rep = 0; rep < REP_P1; ++rep) pg8::gemm_phase(F.lds, DM, DM / 64, S, P, E);
        { OrderKR S2{F.G, F.vcu}; SrcKR P2{(const char*)W_XB(F), (const char*)W_WIN(F), (size_t)256 * DM * 2}; EpiKR E2{F}; pg8::gemm_phase(F.lds, DM, 8, S2, P2, E2); }
#endif
        if (BOTH(1)) GRID_BAR();
    }
    if (IN(2)) {
#if NAIVE_P2
        NEpiQ eq{F}; naive_gemm(W_CQ(F), 512, W_WUQ(F), 512, T, NQ, 512, eq, gw, NGW, lane_id(), 0);
        NEpiKV ek{F}; naive_gemm(W_CKV(F), 512, W_WUKV(F), 512, T, NKV, 512, ek, gw, NGW, lane_id(), 0);
#else
        kr_finish(F);
        pg8::StaticOrder S; S.init(T, NQ + NKV, F.G, (int)blockIdx.x); SrcP2 P{(const char*)W_CQ(F), (const char*)W_CKV(F), (const char*)W_WUQ(F), (const char*)W_WUKV(F), (size_t)256 * 512 * 2}; EpiP2 E{F};
        for (int rep = 0; rep < REP_P2; ++rep) pg8::gemm_phase(F.lds, 512, 8, S, P, E);
#endif
        if (BOTH(2)) GRID_BAR();
    }
    if (IN(3)) {
#if NAIVE_P3
        p3_naive(F);
#else
        p3_fast(F);
#endif
        if (BOTH(3)) GRID_BAR();
    }
    if (IN(4)) {
#if NAIVE_P4
        NEpiMerge e{F}; naive_gemm(W_ABIN(F), 2048, W_WOAB(F), 2048, T, DM, 2048, e, gw, NGW, lane_id(), 1024);
#else
        OrderP4 S; S.S.init(T, DM, F.G, (int)blockIdx.x); SrcP4 P{(const char*)W_ABIN(F), (const char*)W_WOAB(F), (size_t)256 * 2048 * 2}; EpiP4 E{F};
        for (int rep = 0; rep < REP_P4; ++rep) pg8::gemm_phase(F.lds, 2048, 16, S, P, E);
#endif
        if (BOTH(4)) GRID_BAR();
    }
    if (IN(5)) {
#if NAIVE_P5
        NEpiOut e{F}; naive_gemm(W_MERGED(F), 2048, W_WOUT(F), 2048, T, DM, 2048, e, gw, NGW, lane_id(), 0);
#else
        pg8::StaticOrder S; S.init(T, DM, F.G, (int)blockIdx.x); SrcPlain P{(const char*)W_MERGED(F), (const char*)W_WOUT(F), (size_t)256 * 2048 * 2}; EpiP5 E{F};
        for (int rep = 0; rep < REP_P5; ++rep) pg8::gemm_phase(F.lds, 2048, 32, S, P, E);
#endif
        if (BOTH(5)) GRID_BAR();
    }
    if (IN(6)) p6_final(F);
#undef IN
#undef BOTH
}

extern "C" void kernel_launch(void* const* d_in, const int* in_sizes, int n_in, void* d_out, int out_size, void* d_ws, size_t ws_size, hipStream_t stream) {
    static int grid = 0;
    if (grid == 0) {
        if (n_in != 17 || in_sizes[0] != T * DM || out_size != T * DM || ws_size < WS_END) { fprintf(stderr, "kernel_launch: unexpected shapes (n_in %d, in0 %d, out %d, ws %zu)\n", n_in, n_in > 0 ? in_sizes[0] : -1, out_size, ws_size); grid = -1; return; }
        int dev = 0, cus = 0, per_cu = 0;
        if (hipGetDevice(&dev) != hipSuccess || hipDeviceGetAttribute(&cus, hipDeviceAttributeMultiprocessorCount, dev) != hipSuccess) { grid = -1; return; }
        if (hipFuncSetAttribute((const void*)mk_fwd, hipFuncAttributeMaxDynamicSharedMemorySize, LDS_BYTES) != hipSuccess) { fprintf(stderr, "kernel_launch: hipFuncSetAttribute failed\n"); grid = -1; return; }
        if (hipOccupancyMaxActiveBlocksPerMultiprocessor(&per_cu, (const void*)mk_fwd, NWAVES * 64, LDS_BYTES) != hipSuccess || per_cu < 1) { fprintf(stderr, "kernel_launch: occupancy query reports %d blocks per CU\n", per_cu); }
        (void)hipGetLastError();
        grid = cus;
    }
    if (grid < 0) return;
    if (hipMemsetAsync((char*)d_ws + WS_CTL, 0, CTL_ZERO_BYTES, stream) != hipSuccess) { fprintf(stderr, "kernel_launch: memset failed\n"); return; }
    Args a{};
    for (int i = 0; i < 17; ++i) a.in[i] = d_in[i];
    a.out = (float*)d_out; a.ws = (unsigned char*)d_ws;
    for (int li = 0; li < MK_N_LAUNCHES; ++li) {
        if (MK_N_LAUNCHES == NPHASE) { a.ph_lo = li; a.ph_hi = li + 1; } else { a.ph_lo = li * NPHASE / MK_N_LAUNCHES; a.ph_hi = (li + 1) * NPHASE / MK_N_LAUNCHES; }
        a.li = li;
        hipLaunchKernelGGL(mk_fwd, dim3(grid), dim3(NWAVES * 64), LDS_BYTES, stream, a);
        const hipError_t le = hipPeekAtLastError();
        if (le != hipSuccess) { fprintf(stderr, "kernel_launch: launch %d failed: %s\n", li, hipGetErrorName(le)); break; }
    }
}
```
